# Optimizing an MI355X kernel written in HIP

```python
import math
import jax, jax.numpy as jnp
from jax import lax
import numpy as np

D_MODEL = 2048
BATCH = 16
SEQ = 2048
DEPTH = 4

N_META = 16
GRID_W = 64
Q_BLOCK = 128
ROPE_THETA = 10000.0
EPS = 1e-6

MLA_HEADS = 8
Q_LORA = 512
KV_LORA = 256
NOPE_DIM = 128
ROPE_DIM = 64
V_DIM = 128
QK_HEAD = NOPE_DIM + ROPE_DIM
MLA_WIDTH = MLA_HEADS * V_DIM
MLA_SCALE = 1.0 / math.sqrt(QK_HEAD)

GQA_HEADS = 8
GQA_KV_HEADS = 2
GQA_HEAD_DIM = 128
GQA_WIDTH = GQA_HEADS * GQA_HEAD_DIM
GQA_SCALE = 1.0 / math.sqrt(GQA_HEAD_DIM)

MIX_WIDTH = MLA_WIDTH + GQA_WIDTH

OFF_CQ = 0
OFF_CKV = OFF_CQ + Q_LORA
OFF_KR = OFF_CKV + KV_LORA
OFF_GQ = OFF_KR + ROPE_DIM
OFF_GK = OFF_GQ + GQA_HEADS * GQA_HEAD_DIM
OFF_GV = OFF_GK + GQA_KV_HEADS * GQA_HEAD_DIM
IN_COLS = OFF_GV + GQA_KV_HEADS * GQA_HEAD_DIM

N_EXPERTS = 16
N_GROUPS = 4
EXPERTS_PER_GROUP = N_EXPERTS // N_GROUPS
TOP_K = 2
EXPERT_FF = 1024

ALPHA = (2.0 * DEPTH) ** 0.25
BETA = (8.0 * DEPTH) ** -0.25

kernel_name = "hybrid_mla_gqa_axial_grouped_moe_deepnorm_encoder"


def layer_norm(x, g, b):
    xf = x.astype(jnp.float32)
    mu = jnp.mean(xf, axis=-1, keepdims=True)
    xc = xf - mu
    var = jnp.mean(xc * xc, axis=-1, keepdims=True)
    y = xc * lax.rsqrt(var + EPS) * g.astype(jnp.float32) + b.astype(jnp.float32)
    return y.astype(x.dtype)


def rms_norm(x, g):
    xf = x.astype(jnp.float32)
    y = xf * lax.rsqrt(jnp.mean(xf * xf, axis=-1, keepdims=True) + EPS) * g.astype(jnp.float32)
    return y.astype(x.dtype)


def axial_rope_tables(pos_row, pos_col, rot_dim):
    n = rot_dim // 4
    inv = ROPE_THETA ** (-jnp.arange(n, dtype=jnp.float32) / n)
    ang = jnp.concatenate([pos_row[:, None] * inv, pos_col[:, None] * inv], axis=-1)
    return jnp.cos(ang), jnp.sin(ang)


def apply_rope(x, cos, sin):
    half = x.shape[-1] // 2
    x1, x2 = x[..., :half], x[..., half:]
    c = cos[None, :, None, :].astype(x.dtype)
    s = sin[None, :, None, :].astype(x.dtype)
    return jnp.concatenate([x1 * c - x2 * s, x1 * s + x2 * c], axis=-1)


def bidir_attention(q, k, v, scale):
    B, T, Hq, dk = q.shape
    Hk, dv = k.shape[2], v.shape[-1]
    G = Hq // Hk
    S = T - N_META
    qg = q.reshape(B, T, Hk, G, dk)

    def attend(qb):
        s = jnp.einsum('bqhgd,bkhd->bhgqk', qb, k).astype(jnp.float32) * scale
        p = jax.nn.softmax(s, axis=-1).astype(v.dtype)
        return jnp.einsum('bhgqk,bkhd->bqhgd', p, v)

    out_meta = attend(qg[:, :N_META])
    nb = S // Q_BLOCK
    q_real = qg[:, N_META:].reshape(B, nb, Q_BLOCK, Hk, G, dk).transpose(1, 0, 2, 3, 4, 5)
    out_real = lax.map(attend, q_real)
    out_real = out_real.transpose(1, 0, 2, 3, 4, 5).reshape(B, S, Hk, G, dv)
    out = jnp.concatenate([out_meta, out_real], axis=1)
    return out.reshape(B, T, Hq, dv)


def grouped_moe(h, w_router, router_bias, w_gate, w_up, w_down):
    B, T, D = h.shape
    t = h.reshape(B * T, D)
    scores = jax.nn.sigmoid((t @ w_router).astype(jnp.float32))
    sel = scores + router_bias.astype(jnp.float32)
    grp_score = lax.top_k(sel.reshape(-1, N_GROUPS, EXPERTS_PER_GROUP), 2)[0].sum(-1)
    g_idx = jnp.argmax(grp_score, axis=-1)
    in_group = (jnp.arange(N_EXPERTS) // EXPERTS_PER_GROUP)[None, :] == g_idx[:, None]
    masked = jnp.where(in_group, sel, -jnp.inf)
    _, e_idx = lax.top_k(masked, TOP_K)
    w = jnp.take_along_axis(scores, e_idx, axis=-1)
    w = w / jnp.sum(w, axis=-1, keepdims=True)
    combine = jnp.sum(jax.nn.one_hot(e_idx, N_EXPERTS, dtype=jnp.float32) * w[..., None], axis=1)
    combine = combine.astype(t.dtype)
    y = jnp.zeros_like(t)
    for e in range(N_EXPERTS):
        he = jax.nn.silu(t @ w_gate[e]) * (t @ w_up[e])
        y = y + combine[:, e:e + 1] * (he @ w_down[e])
    return y.reshape(B, T, D)


def setup_inputs(seed: int = 0) -> dict:
    key = jax.random.key(seed)
    ks = jax.random.split(key, 23)

    def nrm(k, shape, scale):
        return jax.random.normal(k, shape, jnp.float32) * scale

    def gain(k, shape):
        return 1.0 + 0.05 * jax.random.normal(k, shape, jnp.float32)

    return {
        "x": nrm(ks[0], (BATCH, SEQ, D_MODEL), 1.0),
        "meta_tokens": nrm(ks[1], (N_META, D_MODEL), 1.0),
        "ln_in_g": gain(ks[2], (D_MODEL,)),
        "ln_in_b": nrm(ks[3], (D_MODEL,), 0.02),
        "w_in": nrm(ks[4], (DEPTH, D_MODEL, IN_COLS), D_MODEL ** -0.5),
        "g_q_lora": gain(ks[5], (DEPTH, Q_LORA)),
        "w_q_b": nrm(ks[6], (DEPTH, Q_LORA, MLA_HEADS * QK_HEAD), Q_LORA ** -0.5),
        "g_kv_lora": gain(ks[7], (DEPTH, KV_LORA)),
        "w_kv_b": nrm(ks[8], (DEPTH, KV_LORA, MLA_HEADS * (NOPE_DIM + V_DIM)), KV_LORA ** -0.5),
        "g_qk_q": gain(ks[9], (DEPTH, GQA_HEAD_DIM)),
        "g_qk_k": gain(ks[10], (DEPTH, GQA_HEAD_DIM)),
        "g_out_mla": gain(ks[11], (DEPTH, MLA_WIDTH)),
        "g_out_gqa": gain(ks[12], (DEPTH, GQA_WIDTH)),
        "w_out": nrm(ks[13], (DEPTH, MIX_WIDTH, D_MODEL), MIX_WIDTH ** -0.5 * BETA),
        "ln1_g": gain(ks[14], (DEPTH, D_MODEL)),
        "ln1_b": nrm(ks[15], (DEPTH, D_MODEL), 0.02),
        "w_router": nrm(ks[16], (D_MODEL, N_EXPERTS), D_MODEL ** -0.5),
        "router_bias": nrm(ks[17], (N_EXPERTS,), 0.01),
        "w_gate": nrm(ks[18], (DEPTH, N_EXPERTS, D_MODEL, EXPERT_FF), D_MODEL ** -0.5),
        "w_up": nrm(ks[19], (DEPTH, N_EXPERTS, D_MODEL, EXPERT_FF), D_MODEL ** -0.5),
        "w_down": nrm(ks[20], (DEPTH, N_EXPERTS, EXPERT_FF, D_MODEL), EXPERT_FF ** -0.5 * BETA),
        "ln2_g": gain(ks[21], (DEPTH, D_MODEL)),
        "ln2_b": nrm(ks[22], (DEPTH, D_MODEL), 0.02),
    }


def reference(x, meta_tokens, ln_in_g, ln_in_b, w_in, g_q_lora, w_q_b, g_kv_lora, w_kv_b,
              g_qk_q, g_qk_k, g_out_mla, g_out_gqa, w_out, ln1_g, ln1_b,
              w_router, router_bias, w_gate, w_up, w_down, ln2_g, ln2_b):
    B, S, D = x.shape
    T = N_META + S
    ROWS = S // GRID_W

    pos_row = jnp.concatenate([jnp.full((N_META,), -1.0, jnp.float32),
                               jnp.repeat(jnp.arange(ROWS, dtype=jnp.float32), GRID_W)])
    pos_col = jnp.concatenate([jnp.arange(N_META, dtype=jnp.float32),
                               jnp.tile(jnp.arange(GRID_W, dtype=jnp.float32), ROWS)])
    cos_a, sin_a = axial_rope_tables(pos_row, pos_col, ROPE_DIM)
    cos_b, sin_b = axial_rope_tables(pos_row, pos_col, GQA_HEAD_DIM)

    meta = jnp.broadcast_to(meta_tokens[None].astype(x.dtype), (B, N_META, D))
    h = layer_norm(jnp.concatenate([meta, x], axis=1), ln_in_g, ln_in_b)

    for l in range(DEPTH):
        u = h @ w_in[l]

        c_q = rms_norm(u[..., OFF_CQ:OFF_CKV], g_q_lora[l])
        q_a = (c_q @ w_q_b[l]).reshape(B, T, MLA_HEADS, QK_HEAD)
        q_nope, q_rope = q_a[..., :NOPE_DIM], apply_rope(q_a[..., NOPE_DIM:], cos_a, sin_a)
        c_kv = rms_norm(u[..., OFF_CKV:OFF_KR], g_kv_lora[l])
        kv = (c_kv @ w_kv_b[l]).reshape(B, T, MLA_HEADS, NOPE_DIM + V_DIM)
        k_nope, v_a = kv[..., :NOPE_DIM], kv[..., NOPE_DIM:]
        k_rope = apply_rope(u[..., OFF_KR:OFF_GQ].reshape(B, T, 1, ROPE_DIM), cos_a, sin_a)
        q_full = jnp.concatenate([q_nope, q_rope], axis=-1)
        k_full = jnp.concatenate([k_nope, jnp.broadcast_to(k_rope, (B, T, MLA_HEADS, ROPE_DIM))], axis=-1)
        o_a = bidir_attention(q_full, k_full, v_a, MLA_SCALE).reshape(B, T, MLA_WIDTH)

        q_b = rms_norm(u[..., OFF_GQ:OFF_GK].reshape(B, T, GQA_HEADS, GQA_HEAD_DIM), g_qk_q[l])
        k_b = rms_norm(u[..., OFF_GK:OFF_GV].reshape(B, T, GQA_KV_HEADS, GQA_HEAD_DIM), g_qk_k[l])
        v_b = u[..., OFF_GV:IN_COLS].reshape(B, T, GQA_KV_HEADS, GQA_HEAD_DIM)
        q_b = apply_rope(q_b, cos_b, sin_b)
        k_b = apply_rope(k_b, cos_b, sin_b)
        o_b = bidir_attention(q_b, k_b, v_b, GQA_SCALE).reshape(B, T, GQA_WIDTH)

        mixed = jnp.concatenate([rms_norm(o_a, g_out_mla[l]), rms_norm(o_b, g_out_gqa[l])], axis=-1) @ w_out[l]
        h = layer_norm(ALPHA * h + mixed, ln1_g[l], ln1_b[l])

        ffn = grouped_moe(h, w_router, router_bias, w_gate[l], w_up[l], w_down[l])
        h = layer_norm(ALPHA * h + ffn, ln2_g[l], ln2_b[l])

    return h[:, N_META:]
```

```cpp
#include <hip/hip_runtime.h>
#include <cstdio>
#include <cstdint>

#ifndef PH_MASK
#define PH_MASK 0xFFF
#endif
#ifndef REP_MASK
#define REP_MASK 0
#endif
#ifndef PROBE_MODE
#define PROBE_MODE 0
#endif
#ifndef SM_TEST
#define SM_TEST 0
#endif
#define NREP(k) (1 + ((REP_MASK >> (k)) & 1))
#ifndef FLEX
#define FLEX 0
#endif
#ifndef Y_F8
#define Y_F8 1
#endif
constexpr float YSCALE8 = 64.f;
typedef unsigned short bf16;
typedef short bf16x8 __attribute__((ext_vector_type(8)));
typedef float f32x4 __attribute__((ext_vector_type(4)));
typedef float f32x16 __attribute__((ext_vector_type(16)));
typedef unsigned u32x4 __attribute__((ext_vector_type(4)));
typedef unsigned u32x2 __attribute__((ext_vector_type(2)));

constexpr int BATCH = 16, SEQ = 2048, DM = 2048, DEPTH = 4, NMETA = 16, T = SEQ + NMETA, M = BATCH * T;
constexpr int QL = 512, KVL = 256, NOPE = 128, ROPE = 64, QKH = 192, NH = 8;
constexpr int GH = 8, GKV = 2, GD = 128;
constexpr int INC = 2368;
constexpr int R_CQ = 0, R_CKV = 512, R_KR = 768, R_GQ = 832, R_GK = 1856, R_GV = 2112;
constexpr int UC = 2560, U_CQ = 0, U_CKV = 512, U_GQ = 768, U_GK = 1792, U_GV = 2048, U_KR = 2304;
constexpr int NE = 16, EFF = 1024;
constexpr float EPS = 1e-6f;
constexpr float ALPHA = 1.681792830507429f;
constexpr float MLA_SCALE = 0.07216878364870322f;
constexpr float GQA_SCALE = 0.08838834764831845f;
constexpr float QSC_M = MLA_SCALE * 1.4426950408889634f * 16.f, QSC_G = GQA_SCALE * 1.4426950408889634f * 16.f;
constexpr int QSCALE_E8 = 0x7b7b7b7b;

__device__ const float INV16[16] = {1.000000000e+00f, 5.623413324e-01f, 3.162277639e-01f, 1.778279394e-01f, 1.000000015e-01f, 5.623413250e-02f, 3.162277490e-02f, 1.778279431e-02f,
                                    9.999999776e-03f, 5.623413250e-03f, 3.162277630e-03f, 1.778279431e-03f, 1.000000047e-03f, 5.623413017e-04f, 3.162277571e-04f, 1.778279402e-04f};
__device__ const float INV32[32] = {1.000000000e+00f, 7.498942614e-01f, 5.623413324e-01f, 4.216965139e-01f, 3.162277639e-01f, 2.371373773e-01f, 1.778279394e-01f, 1.333521307e-01f,
                                    1.000000015e-01f, 7.498941571e-02f, 5.623413250e-02f, 4.216965288e-02f, 3.162277490e-02f, 2.371373773e-02f, 1.778279431e-02f, 1.333521493e-02f,
                                    9.999999776e-03f, 7.498941850e-03f, 5.623413250e-03f, 4.216964822e-03f, 3.162277630e-03f, 2.371373586e-03f, 1.778279431e-03f, 1.333521446e-03f,
                                    1.000000047e-03f, 7.498942432e-04f, 5.623413017e-04f, 4.216965172e-04f, 3.162277571e-04f, 2.371373703e-04f, 1.778279402e-04f, 1.333521504e-04f};

constexpr size_t MiB = 1u << 20;
constexpr size_t SZ_ROW2K = (size_t)M * 2048 * 2;
constexpr size_t WS_CTL = 0;
constexpr size_t CTL_ZERO_BYTES = 256 * 1024;
constexpr size_t OFF_CNT = 128 * 1024;
constexpr size_t WS_TAB = 8 * MiB;
constexpr size_t OFF_COSA = WS_TAB, OFF_SINA = OFF_COSA + (size_t)T * 32 * 4, OFF_COSB = OFF_SINA + (size_t)T * 32 * 4, OFF_SINB = OFF_COSB + (size_t)T * 64 * 4;
constexpr size_t WS_ROUTE = 12 * MiB;
constexpr size_t OFF_EIDX = WS_ROUTE, OFF_WTS = OFF_EIDX + (size_t)M * 8, OFF_LIST = OFF_WTS + (size_t)M * 8;
constexpr size_t OFF_SSQ = 20 * MiB, OFF_SSKV = 21 * MiB + 512 * 1024, OFF_SSO = 22 * MiB;
constexpr size_t OFF_WRT = 25 * MiB;
constexpr size_t WS_H = 32 * MiB;
constexpr size_t WS_U = WS_H + 130 * MiB;
constexpr size_t WS_QM = WS_U + 162 * MiB;
constexpr size_t WS_KVB = WS_QM + 98 * MiB;
constexpr size_t WS_Y = WS_U;
constexpr size_t WS_OA = WS_KVB + 130 * MiB;
constexpr size_t WS_HE = WS_OA;
constexpr size_t WS_Z = WS_OA + 130 * MiB;
constexpr size_t WS_H1 = WS_Z + 130 * MiB;
constexpr size_t WS_END = WS_H1 + 130 * MiB;
static_assert(WS_Y + (size_t)2 * M * 2048 * 2 <= WS_OA, "Y fits in U|QM|KVB");

__device__ __forceinline__ unsigned f2bf(float f) { unsigned u = __float_as_uint(f); return (u + 0x7fffu + ((u >> 16) & 1u)) >> 16; }
__device__ __forceinline__ float bf2f(unsigned b) { return __uint_as_float(b << 16); }
__device__ __forceinline__ unsigned pk2(float lo, float hi) { unsigned r; asm("v_cvt_pk_bf16_f32 %0, %1, %2" : "=v"(r) : "v"(lo), "v"(hi)); return r; }
__device__ __forceinline__ float clamp8(float x) { return __builtin_amdgcn_fmed3f(x, -448.f, 448.f); }
__device__ __forceinline__ unsigned pack4_fp8(float a, float b, float c, float d) { unsigned w = 0u; w = __builtin_amdgcn_cvt_pk_fp8_f32(clamp8(a), clamp8(b), w, false); w = __builtin_amdgcn_cvt_pk_fp8_f32(clamp8(c), clamp8(d), w, true); return w; }
__device__ __forceinline__ float wave_sum(float v) {
#pragma unroll
    for (int o = 1; o < 64; o <<= 1) v += __shfl_xor(v, o);
    return v;
}
__device__ __forceinline__ float wave_max(float v) {
#pragma unroll
    for (int o = 1; o < 64; o <<= 1) v = fmaxf(v, __shfl_xor(v, o));
    return v;
}
__device__ __forceinline__ void ld8(const bf16* p, float (&v)[8]) {
    const u32x4 w = *(const u32x4*)p;
    v[0] = bf2f(w.x & 0xffffu); v[1] = bf2f(w.x >> 16); v[2] = bf2f(w.y & 0xffffu); v[3] = bf2f(w.y >> 16);
    v[4] = bf2f(w.z & 0xffffu); v[5] = bf2f(w.z >> 16); v[6] = bf2f(w.w & 0xffffu); v[7] = bf2f(w.w >> 16);
}
__device__ __forceinline__ void st8(bf16* p, const float (&v)[8]) {
    u32x4 w; w.x = pk2(v[0], v[1]); w.y = pk2(v[2], v[3]); w.z = pk2(v[4], v[5]); w.w = pk2(v[6], v[7]);
    *(u32x4*)p = w;
}
__device__ __forceinline__ int crow(int r, int hi) { return (r & 3) + 8 * (r >> 2) + 4 * hi; }

__device__ __forceinline__ void sincos_d(double x, double& s, double& c) {
    const double k = rint(x * 0.63661977236758134308);
    double r = fma(-k, 1.57079632679489655800, x); r = fma(-k, 6.12323399573676603587e-17, r);
    const int q = ((int)k) & 3; const double r2 = r * r;
    const double sp = r * (1.0 + r2 * (-1.0 / 6 + r2 * (1.0 / 120 + r2 * (-1.0 / 5040 + r2 * (1.0 / 362880 + r2 * (-1.0 / 39916800 + r2 * (1.0 / 6227020800.0 + r2 * (-1.0 / 1307674368000.0))))))));
    const double cp = 1.0 + r2 * (-0.5 + r2 * (1.0 / 24 + r2 * (-1.0 / 720 + r2 * (1.0 / 40320 + r2 * (-1.0 / 3628800 + r2 * (1.0 / 479001600 + r2 * (-1.0 / 87178291200.0 + r2 * (1.0 / 20922789888000.0))))))));
    s = (q == 0) ? sp : (q == 1) ? cp : (q == 2) ? -sp : -cp;
    c = (q == 0) ? cp : (q == 1) ? -sp : (q == 2) ? -cp : sp;
}

__device__ __forceinline__ void ln_apply(f32x4 (&v)[8], const float* g, const float* b, int lane) {
    float s = 0.f;
#pragma unroll
    for (int j = 0; j < 8; ++j) s += (v[j].x + v[j].y) + (v[j].z + v[j].w);
    const float mean = wave_sum(s) * (1.f / DM); float s2 = 0.f;
#pragma unroll
    for (int j = 0; j < 8; ++j) { v[j] = v[j] - mean; s2 += (v[j].x * v[j].x + v[j].y * v[j].y) + (v[j].z * v[j].z + v[j].w * v[j].w); }
    const float rstd = 1.f / sqrtf(wave_sum(s2) * (1.f / DM) + EPS);
#pragma unroll
    for (int j = 0; j < 8; ++j) { const f32x4 gg = *(const f32x4*)(g + 4 * lane + 256 * j), bb = *(const f32x4*)(b + 4 * lane + 256 * j); v[j] = v[j] * rstd * gg + bb; }
}
__device__ __forceinline__ void store_row_bf16(bf16* orow, const f32x4 (&v)[8], int lane) {
#pragma unroll
    for (int j = 0; j < 8; ++j) { u32x2 w; w.x = pk2(v[j].x, v[j].y); w.y = pk2(v[j].z, v[j].w); *(u32x2*)(orow + 4 * lane + 256 * j) = w; }
}
__device__ __forceinline__ void store_row_fp8(unsigned char* orow, const f32x4 (&v)[8], int lane) {
#pragma unroll
    for (int j = 0; j < 8; ++j) *(unsigned*)(orow + 4 * lane + 256 * j) = pack4_fp8(v[j].x, v[j].y, v[j].z, v[j].w);
}
__device__ __forceinline__ void load_row_bf16(const bf16* irow, f32x4 (&v)[8], int lane) {
#pragma unroll
    for (int j = 0; j < 8; ++j) { const u32x2 w = *(const u32x2*)(irow + 4 * lane + 256 * j); v[j] = (f32x4){bf2f(w.x & 0xffffu), bf2f(w.x >> 16), bf2f(w.y & 0xffffu), bf2f(w.y >> 16)}; }
}

__device__ __forceinline__ void load_row_raw(const bf16* irow, u32x2 (&r)[8], int lane) {
#pragma unroll
    for (int j = 0; j < 8; ++j) r[j] = *(const u32x2*)(irow + 4 * lane + 256 * j);
}
__device__ __forceinline__ void unpack_row(const u32x2 (&r)[8], f32x4 (&v)[8]) {
#pragma unroll
    for (int j = 0; j < 8; ++j) v[j] = (f32x4){bf2f(r[j].x & 0xffffu), bf2f(r[j].x >> 16), bf2f(r[j].y & 0xffffu), bf2f(r[j].y >> 16)};
}

__device__ __forceinline__ void ln_in_row(int m, const float* x, const float* meta, const float* g, const float* b, bf16* H, int lane) {
    const int bb = m / T, t = m % T;
    const float* src = t < NMETA ? meta + (size_t)t * DM : x + ((size_t)bb * SEQ + (t - NMETA)) * DM;
    f32x4 v[8];
#pragma unroll
    for (int j = 0; j < 8; ++j) v[j] = *(const f32x4*)(src + 4 * lane + 256 * j);
    ln_apply(v, g, b, lane);
    store_row_bf16(H + (size_t)m * DM, v, lane);
}
__device__ __forceinline__ void unpack8(const u32x4 w, float (&v)[8]) {
    v[0] = bf2f(w.x & 0xffffu); v[1] = bf2f(w.x >> 16); v[2] = bf2f(w.y & 0xffffu); v[3] = bf2f(w.y >> 16); v[4] = bf2f(w.z & 0xffffu); v[5] = bf2f(w.z >> 16); v[6] = bf2f(w.w & 0xffffu); v[7] = bf2f(w.w >> 16);
}
__device__ __forceinline__ void norm_rope_seg(float (&v)[8], const f32x4 g0, const f32x4 g1, const f32x4 c0, const f32x4 c1, const f32x4 s0, const f32x4 s1, bool first, float (&o)[8]) {
    float s = 0.f;
#pragma unroll
    for (int i = 0; i < 8; ++i) s += v[i] * v[i];
    s += __shfl_xor(s, 1); s += __shfl_xor(s, 2); s += __shfl_xor(s, 4); s += __shfl_xor(s, 8);
    const float rs = 1.f / sqrtf(s * (1.f / GD) + EPS);
    const float g[8] = {g0[0], g0[1], g0[2], g0[3], g1[0], g1[1], g1[2], g1[3]}, cs[8] = {c0[0], c0[1], c0[2], c0[3], c1[0], c1[1], c1[2], c1[3]}, sn[8] = {s0[0], s0[1], s0[2], s0[3], s1[0], s1[1], s1[2], s1[3]};
#pragma unroll
    for (int i = 0; i < 8; ++i) { const float y = v[i] * rs * g[i]; const float py = __shfl_xor(y, 8); o[i] = first ? (y * cs[i] - py * sn[i]) : (py * sn[i] + y * cs[i]); }
}
__device__ __forceinline__ void st8_fp8(unsigned char* p, const float (&v)[8]) { u32x2 w; w.x = pack4_fp8(v[0], v[1], v[2], v[3]); w.y = pack4_fp8(v[4], v[5], v[6], v[7]); *(u32x2*)p = w; }
__device__ __forceinline__ void rowprep_fast(const bf16* u, int m, unsigned char* gq8, unsigned char* gk8, unsigned char* kr8, const float* gqq, const float* gqk, const float* cosA, const float* sinA, const float* cosB, const float* sinB, int lane) {
    const int t = m % T;
    const int d0 = (lane & 15) * 8, j0 = d0 & 63; const bool first = (lane & 15) < 8;
    const int ka = (lane & 7) * 8, ja = ka & 31; const bool firsta = (lane & 7) < 4;
    const u32x4 z4 = {0u, 0u, 0u, 0u};
    const u32x4 r0 = *(const u32x4*)(u + U_GQ + 8 * lane), r1 = *(const u32x4*)(u + U_GQ + 512 + 8 * lane);
    const u32x4 r2 = lane < 32 ? *(const u32x4*)(u + U_GK + 8 * lane) : z4, r3 = lane < 8 ? *(const u32x4*)(u + U_KR + 8 * lane) : z4;
    const f32x4 gq0 = *(const f32x4*)(gqq + d0), gq1 = *(const f32x4*)(gqq + d0 + 4), gk0 = *(const f32x4*)(gqk + d0), gk1 = *(const f32x4*)(gqk + d0 + 4);
    const f32x4 cb0 = *(const f32x4*)(cosB + t * 64 + j0), cb1 = *(const f32x4*)(cosB + t * 64 + j0 + 4), sb0 = *(const f32x4*)(sinB + t * 64 + j0), sb1 = *(const f32x4*)(sinB + t * 64 + j0 + 4);
    const f32x4 ca0 = *(const f32x4*)(cosA + t * 32 + ja), ca1 = *(const f32x4*)(cosA + t * 32 + ja + 4), sa0 = *(const f32x4*)(sinA + t * 32 + ja), sa1 = *(const f32x4*)(sinA + t * 32 + ja + 4);
    float v[8], o[8];
    { const f32x4 gs0 = gq0 * QSC_G, gs1 = gq1 * QSC_G;
    unpack8(r0, v); norm_rope_seg(v, gs0, gs1, cb0, cb1, sb0, sb1, first, o); st8_fp8(gq8 + (size_t)m * 1024 + 8 * lane, o);
    unpack8(r1, v); norm_rope_seg(v, gs0, gs1, cb0, cb1, sb0, sb1, first, o); st8_fp8(gq8 + (size_t)m * 1024 + 512 + 8 * lane, o); }
    unpack8(r2, v); norm_rope_seg(v, gk0, gk1, cb0, cb1, sb0, sb1, first, o); if (lane < 32) st8_fp8(gk8 + (size_t)m * 256 + 8 * lane, o);
    { unpack8(r3, v); const float cs[8] = {ca0[0], ca0[1], ca0[2], ca0[3], ca1[0], ca1[1], ca1[2], ca1[3]}, sn[8] = {sa0[0], sa0[1], sa0[2], sa0[3], sa1[0], sa1[1], sa1[2], sa1[3]};
#pragma unroll
      for (int i = 0; i < 8; ++i) { const float py = __shfl_xor(v[i], 4); o[i] = firsta ? (v[i] * cs[i] - py * sn[i]) : (py * sn[i] + v[i] * cs[i]); }
      if (lane < 8) st8_fp8(kr8 + (size_t)m * 64 + 8 * lane, o); }
}
__device__ __forceinline__ int ucol_to_ref(int c) {
    if (c < 768) return c;
    if (c < 1792) return R_GQ + (c - 768);
    if (c < 2048) return R_GK + (c - 1792);
    if (c < 2304) return R_GV + (c - 2048);
    if (c < 2368) return R_KR + (c - 2304);
    return -1;
}
__device__ __forceinline__ f32x4 cvt4(const u32x2 w) { return (f32x4){bf2f(w.x & 0xffffu), bf2f(w.x >> 16), bf2f(w.y & 0xffffu), bf2f(w.y >> 16)}; }
__device__ __forceinline__ f32x4 cvt4_fp8(const unsigned w) { const auto lo = __builtin_amdgcn_cvt_pk_f32_fp8((int)w, false), hi = __builtin_amdgcn_cvt_pk_f32_fp8((int)w, true); return (f32x4){lo[0], lo[1], hi[0], hi[1]}; }
__device__ __forceinline__ void combine_rows2(int m, const bf16* H1, const bf16* Y, const float* wts, const float* g, const float* b, bf16* Hn, float* out, bool last, int lane) {
    u32x2 h0[8], h1[8];
    const bf16* hp = H1 + (size_t)m * DM + 4 * lane;
    f32x4 v0[8], v1[8];
    if (Y_F8) {
        unsigned ya[8], yb[8], yc[8], yd[8]; const unsigned char* yp = (const unsigned char*)Y + (size_t)(2 * m) * DM + 4 * lane;
#pragma unroll
        for (int j = 0; j < 8; ++j) { h0[j] = *(const u32x2*)(hp + 256 * j); h1[j] = *(const u32x2*)(hp + DM + 256 * j);
            ya[j] = *(const unsigned*)(yp + 256 * j); yb[j] = *(const unsigned*)(yp + DM + 256 * j); yc[j] = *(const unsigned*)(yp + 2 * DM + 256 * j); yd[j] = *(const unsigned*)(yp + 3 * DM + 256 * j); }
        f32x4 w = *(const f32x4*)(wts + 2 * m); w = w * (1.f / YSCALE8);
#pragma unroll
        for (int j = 0; j < 8; ++j) { v0[j] = cvt4(h0[j]) * ALPHA + cvt4_fp8(ya[j]) * w.x + cvt4_fp8(yb[j]) * w.y; v1[j] = cvt4(h1[j]) * ALPHA + cvt4_fp8(yc[j]) * w.z + cvt4_fp8(yd[j]) * w.w; }
    } else {
        u32x2 ya[8], yb[8], yc[8], yd[8]; const bf16* yp = Y + (size_t)(2 * m) * DM + 4 * lane;
#pragma unroll
        for (int j = 0; j < 8; ++j) { h0[j] = *(const u32x2*)(hp + 256 * j); h1[j] = *(const u32x2*)(hp + DM + 256 * j);
            ya[j] = *(const u32x2*)(yp + 256 * j); yb[j] = *(const u32x2*)(yp + DM + 256 * j); yc[j] = *(const u32x2*)(yp + 2 * DM + 256 * j); yd[j] = *(const u32x2*)(yp + 3 * DM + 256 * j); }
        const f32x4 w = *(const f32x4*)(wts + 2 * m);
#pragma unroll
        for (int j = 0; j < 8; ++j) { v0[j] = cvt4(h0[j]) * ALPHA + cvt4(ya[j]) * w.x + cvt4(yb[j]) * w.y; v1[j] = cvt4(h1[j]) * ALPHA + cvt4(yc[j]) * w.z + cvt4(yd[j]) * w.w; }
    }
    ln_apply(v0, g, b, lane); ln_apply(v1, g, b, lane);
    if (!last) { store_row_bf16(Hn + (size_t)m * DM, v0, lane); store_row_bf16(Hn + (size_t)(m + 1) * DM, v1, lane); }
    else {
        { const int bb = m / T, t = m % T; if (t >= NMETA) { float* o = out + ((size_t)bb * SEQ + (t - NMETA)) * DM;
#pragma unroll
            for (int j = 0; j < 8; ++j) *(f32x4*)(o + 4 * lane + 256 * j) = v0[j]; } }
        { const int bb = (m + 1) / T, t = (m + 1) % T; if (t >= NMETA) { float* o = out + ((size_t)bb * SEQ + (t - NMETA)) * DM;
#pragma unroll
            for (int j = 0; j < 8; ++j) *(f32x4*)(o + 4 * lane + 256 * j) = v1[j]; } }
    }
}
#define LAS __attribute__((address_space(3)))
#define GAS __attribute__((address_space(1)))
constexpr int NWAVES = 8;
constexpr int RING_BYTES = 131072, LDSCTL_OFF = RING_BYTES, LDS_BYTES = 147456;
constexpr int LC_BAR = 0;
constexpr int LC_PRE = 16;
constexpr int LC_CNT = 40;
constexpr int LC_ECNT = 64;
constexpr int LC_STASH = 1024;
constexpr int LC_TAB = 256;
constexpr size_t WL_WIN = 0, WL_WQB = WL_WIN + (size_t)UC * DM * 2, WL_WKVB = WL_WQB + (size_t)1536 * QL * 2, WL_WOUT = WL_WKVB + (size_t)2048 * KVL * 2,
                 WL_WGU = WL_WOUT + (size_t)2048 * 2048 * 2, WL_WD = WL_WGU + (size_t)NE * 2048 * 2048 * 2, WL_SIZE = WL_WD + (size_t)NE * 2048 * 1024 * 2;
constexpr size_t WS_WT = WS_END;
constexpr size_t WS_END2 = WS_WT + 4 * WL_SIZE;
constexpr size_t WS_H1Q = WS_END2;
constexpr size_t WS_END3 = WS_H1Q + 66 * MiB;
constexpr size_t WS_QM8 = WS_END3, WS_GQ8 = WS_QM8 + (size_t)(M + 64) * 1536, WS_GK8 = WS_GQ8 + (size_t)(M + 64) * 1024, WS_KN8 = WS_GK8 + (size_t)(M + 64) * 256, WS_KR8 = WS_KN8 + (size_t)(M + 64) * 1024;
constexpr size_t WS_END4 = ((WS_KR8 + (size_t)(M + 64) * 64 + MiB - 1) / MiB) * MiB;
#ifndef MOE_F8_GU
#define MOE_F8_GU 1
#endif
#ifndef MOE_F8_DN
#define MOE_F8_DN 1
#endif
constexpr float WSCALE8 = 32.f, WDSCALE8 = 64.f, HESCALE8 = 8.f;
constexpr int CW_BAR = 4096;

__device__ __forceinline__ int lane_id() { int r; asm volatile("v_mbcnt_lo_u32_b32 %0, -1, 0\n\tv_mbcnt_hi_u32_b32 %0, -1, %0" : "=v"(r)); return r; }
#define XB_TMO      128
#define XB_XCNT(j)  (256  + 64 * (j))
#define XB_XSUB(j)  (1280 + 64 * (j))
#define XB_XGEN(j)  (2304 + 64 * (j))
#define XB_TOP      3328
#define XB_TOPGEN   3392
#define XCD_BAR_WORDS 3456
#define XB_SPIN_CAP (1u << 20)
__device__ __forceinline__ unsigned xb_ld(unsigned* p)              { return __hip_atomic_load(p, __ATOMIC_RELAXED, __HIP_MEMORY_SCOPE_AGENT); }
__device__ __forceinline__ unsigned xb_add(unsigned* p, unsigned v) { return __hip_atomic_fetch_add(p, v, __ATOMIC_RELAXED, __HIP_MEMORY_SCOPE_AGENT); }
__device__ __forceinline__ unsigned xb_xcc_id() { return (unsigned)__builtin_amdgcn_s_getreg((3 << 11) | 20) & 0xFu; }
#define XB_SPIN(cond, bar) do { unsigned _sp = 0; while (cond) { __builtin_amdgcn_s_sleep(1); \
    if ((++_sp & 255u) == 0u) { if (xb_ld(&(bar)[XB_TMO])) break; if (_sp > XB_SPIN_CAP) { atomicAdd(&(bar)[XB_TMO], 1u); break; } } } } while (0)
struct XcdBarrier { unsigned* bar; unsigned x; volatile LAS unsigned* st; };
__device__ __forceinline__ XcdBarrier xcd_barrier_post(unsigned* bar, volatile LAS unsigned* st) {
    XcdBarrier b; b.bar = bar; b.x = xb_xcc_id(); b.st = st;
    if (__builtin_amdgcn_readfirstlane(threadIdx.x) == 0 && lane_id() == 0) (void)xb_add(&bar[XB_XCNT(b.x)], 1u);
    return b;
}
__device__ __forceinline__ void xcd_barrier_complete(unsigned* bar, unsigned x, unsigned& nloc, unsigned& nx) {
    const unsigned G = gridDim.x * gridDim.y * gridDim.z;
    unsigned sum, cnt, mine, sp = 0u;
    for (;;) {
        sum = 0u; cnt = 0u; mine = 0u;
#pragma unroll
        for (unsigned j = 0; j < 16; ++j) { const unsigned c = xb_ld(&bar[XB_XCNT(j)]); sum += c; cnt += (c > 0u) ? 1u : 0u; mine = (j == x) ? c : mine; }
        if (sum == G) break;
        __builtin_amdgcn_s_sleep(1);
        if ((++sp & 255u) == 0u) { if (xb_ld(&bar[XB_TMO])) break; if (sp > XB_SPIN_CAP) { atomicAdd(&bar[XB_TMO], 1u); break; } }
    }
    nloc = mine > 0u ? mine : 1u; nx = cnt > 0u ? cnt : 1u;
}
__device__ __forceinline__ void xcd_barrier(const XcdBarrier& b, bool leader) {
    asm volatile("s_waitcnt vmcnt(0)" ::: "memory");
    __syncthreads();
    if (leader) {
        unsigned* bar = b.bar;
        __builtin_amdgcn_s_waitcnt(0);
        unsigned nloc = b.st[0], nx = b.st[1];
        if (nloc == 0u) { xcd_barrier_complete(bar, b.x, nloc, nx); b.st[0] = nloc; b.st[1] = nx; }
        const unsigned old = xb_add(&bar[XB_XSUB(b.x)], 1u);
        const unsigned gen = old / nloc;
        if (old + 1u == (gen + 1u) * nloc) {
            __builtin_amdgcn_fence(__ATOMIC_RELEASE, "agent");
            asm volatile("s_waitcnt vmcnt(0)" ::: "memory");
            const unsigned og = xb_add(&bar[XB_TOP], 1u);
            const unsigned tg = og / nx;
            if (og + 1u == (tg + 1u) * nx) xb_add(&bar[XB_TOPGEN], 1u);
            else XB_SPIN(xb_ld(&bar[XB_TOPGEN]) == tg, bar);
            __builtin_amdgcn_fence(__ATOMIC_ACQUIRE, "agent");
            xb_add(&bar[XB_XGEN(b.x)], 1u);
            asm volatile("s_waitcnt vmcnt(0)" ::: "memory");
        } else {
            XB_SPIN(xb_ld(&bar[XB_XGEN(b.x)]) == gen, bar);
            __builtin_amdgcn_fence(__ATOMIC_ACQUIRE, "agent");
            asm volatile("s_waitcnt vmcnt(0)" ::: "memory");
        }
    }
    __syncthreads();
}

__device__ __forceinline__ void xwait(unsigned* cnt, unsigned target, unsigned* tmo, bool leader) {
    __syncthreads();
    if (leader) {
        unsigned sp = 0;
        while (xb_ld(cnt) < target) { __builtin_amdgcn_s_sleep(2); if ((++sp & 255u) == 0u) { if (xb_ld(tmo)) break; if (sp > XB_SPIN_CAP) { atomicAdd(tmo, 1u); break; } } }
        __builtin_amdgcn_fence(__ATOMIC_ACQUIRE, "agent");
        asm volatile("s_waitcnt vmcnt(0)" ::: "memory");
    }
    __syncthreads();
}
__device__ __forceinline__ void xsync(unsigned* cnt, unsigned target, unsigned* tmo, bool leader) {
    asm volatile("s_waitcnt vmcnt(0)" ::: "memory");
    __syncthreads();
    if (leader) {
        __builtin_amdgcn_fence(__ATOMIC_RELEASE, "agent");
        asm volatile("s_waitcnt vmcnt(0)" ::: "memory");
        (void)xb_add(cnt, 1u);
        unsigned sp = 0;
        while (xb_ld(cnt) < target) { __builtin_amdgcn_s_sleep(2); if ((++sp & 255u) == 0u) { if (xb_ld(tmo)) break; if (sp > XB_SPIN_CAP) { atomicAdd(tmo, 1u); break; } } }
        __builtin_amdgcn_fence(__ATOMIC_ACQUIRE, "agent");
        asm volatile("s_waitcnt vmcnt(0)" ::: "memory");
    }
    __syncthreads();
}

namespace pg8 {
typedef float f32x2 __attribute__((ext_vector_type(2)));
constexpr int BM = 256, BK = 64, HALF = 128, HTB = HALF * BK * 2, STAGE_BYTES = 8 * HTB;
__host__ __device__ __forceinline__ int lds_byte(int r, int c) { const int st = (r >> 4) * 2 + (c >> 5), rr = r & 15, cc = c & 31, ob = rr * 64 + cc * 2; return st * 1024 + (ob ^ (((ob >> 9) & 1) << 5)); }
__host__ __device__ __forceinline__ void stage_rc(int b, int& R, int& C) { const int st = b / 1024, sb = b % 1024, swz = sb ^ (((sb >> 9) & 1) << 5); R = (st >> 1) * 16 + swz / 64; C = (st & 1) * 32 + (swz % 64) / 2; }
__host__ __device__ __forceinline__ int perm32(int rho) { const int n = rho >> 4, i = rho & 15; return 8 * (i >> 2) + 4 * n + (i & 3); }
struct Unit { int pm, pn, e, nv; };

__device__ __forceinline__ unsigned cvt_pk_bf16(float lo, float hi) { unsigned r; asm volatile("v_cvt_pk_bf16_f32 %0, %1, %2" : "=v"(r) : "v"(lo), "v"(hi)); return r; }
__device__ __forceinline__ u32x4 pack8(const f32x4& v0, const f32x4& v1) { u32x4 w; w.x = cvt_pk_bf16(v0[0], v0[1]); w.y = cvt_pk_bf16(v0[2], v0[3]); w.z = cvt_pk_bf16(v1[0], v1[1]); w.w = cvt_pk_bf16(v1[2], v1[3]); return w; }

typedef int v8i __attribute__((ext_vector_type(8)));
typedef int v4i __attribute__((ext_vector_type(4)));
__device__ __forceinline__ v8i cat8(const bf16x8 a, const bf16x8 b) { const v4i x = __builtin_bit_cast(v4i, a), y = __builtin_bit_cast(v4i, b); return __builtin_shufflevector(x, y, 0, 1, 2, 3, 4, 5, 6, 7); }
constexpr int FTAB = 2048 - 256;
template <bool F8, class Epi, class Sched>
__device__ __forceinline__ void gemm_phase(LAS unsigned char* lds, volatile LAS unsigned* tab  , int wave_in, const void* A, int K, const Sched& S, const Epi& E) {
    int tid = wave_in * 64 + lane_id(); asm volatile("" : "+v"(tid));
    const int wid = __builtin_amdgcn_readfirstlane(tid >> 6), lane = tid & 63, wr = wid >> 2, wc = wid & 3, fr = lane & 15, fq = lane >> 4;
    constexpr int ESZ = F8 ? 1 : 2;
    const int nt = K * ESZ / 128;
    int sR0, sCB; unsigned voffB[2];
#pragma unroll
    for (int i = 0; i < 2; ++i) { int R, CB;
        if constexpr (F8) { const int sl = tid + i * 512; R = sl >> 3; CB = ((sl & 7) ^ ((R >> 1) & 7)) * 16; }
        else { int C; stage_rc(tid * 16 + i * 8192, R, C); CB = C * 2; }
        if (i == 0) { sR0 = R; sCB = CB; }
        const int Rb = (R & ~31) + perm32(R & 31); voffB[i] = (unsigned)(Rb * K * ESZ + CB); }
    const size_t kstep = (size_t)128;
    const size_t hstep = (size_t)HALF * K * ESZ;
    const int lda = S.lda;
    const size_t hstepA = (size_t)HALF * lda * ESZ;
    const unsigned voffA0 = (unsigned)(sR0 * lda * ESZ + sCB), voffA1 = (unsigned)((sR0 + 64) * lda * ESZ + sCB);
    const unsigned ldsw = (unsigned)wid * 1024u;
    const int aoff = F8 ? (wr * 64 + fr) * 128 + (((2 * fq) ^ ((fr >> 1) & 7)) * 16) : lds_byte(wr * 64 + fr, fq * 8), boff = F8 ? (wc * 32 + fr) * 128 + (((2 * fq) ^ ((fr >> 1) & 7)) * 16) : lds_byte(wc * 32 + fr, fq * 8);
    const int aoffx = aoff ^ 16, boffx = boff ^ 16;
    const char* Ab = (const char*)A;
#define PG8_SA(b, h) (((b) * 2 + (h)) * HTB)
#define PG8_SB(b, h) ((4 + (b) * 2 + (h)) * HTB)
#define PG8_GLDS(gp, lo) __builtin_amdgcn_global_load_lds((const unsigned*)(gp), (LAS unsigned*)(lds + (lo)), 16, 0, 0)
#define PG8_STAGE_B(bufoff, gbase) do { _Pragma("unroll") for (int _i = 0; _i < 2; ++_i) PG8_GLDS((const char*)(gbase) + voffB[_i], (bufoff) + ldsw + _i * 8192); } while (0)
#define PG8_STAGE_A(bufoff, kofs, h, nx) do { \
        if constexpr (Sched::GATHER) { volatile LAS unsigned* _tb = tab + ((((ui) + ((nx) ? 1 : 0)) & 1) << 8) + (h) * HALF + sR0; const unsigned _o0 = _tb[0], _o1 = _tb[64]; \
            PG8_GLDS(Ab + (kofs) + (size_t)(_o0 + (unsigned)sCB), (bufoff) + ldsw); PG8_GLDS(Ab + (kofs) + (size_t)(_o1 + (unsigned)sCB), (bufoff) + ldsw + 8192); } \
        else { const char* _b = ((nx) ? nA : cA) + (kofs) + (size_t)(h) * hstepA; PG8_GLDS(_b + voffA0, (bufoff) + ldsw); PG8_GLDS(_b + voffA1, (bufoff) + ldsw + 8192); } } while (0)
#define PG8_LDA(dst, b, h) do { if constexpr (F8) { _Pragma("unroll") for (int m = 0; m < 4; ++m) dst##8[m] = cat8(*(const LAS bf16x8*)(lds + PG8_SA(b, h) + aoff + m * 2048), *(const LAS bf16x8*)(lds + PG8_SA(b, h) + aoffx + m * 2048)); } \
        else { _Pragma("unroll") for (int m = 0; m < 4; ++m) _Pragma("unroll") for (int k = 0; k < 2; ++k) dst[m][k] = *(const LAS bf16x8*)(lds + PG8_SA(b, h) + aoff + m * 2048 + k * 1024); } } while (0)
#define PG8_LDB(dst, b, h) do { if constexpr (F8) { _Pragma("unroll") for (int n = 0; n < 2; ++n) dst##8[n] = cat8(*(const LAS bf16x8*)(lds + PG8_SB(b, h) + boff + n * 2048), *(const LAS bf16x8*)(lds + PG8_SB(b, h) + boffx + n * 2048)); } \
        else { _Pragma("unroll") for (int n = 0; n < 2; ++n) _Pragma("unroll") for (int k = 0; k < 2; ++k) dst[n][k] = *(const LAS bf16x8*)(lds + PG8_SB(b, h) + boff + n * 2048 + k * 1024); } } while (0)
#define PG8_MMA(ai, bj, At, Bt) do { __builtin_amdgcn_s_setprio(1); \
        if constexpr (F8) { _Pragma("unroll") for (int m = 0; m < 4; ++m) _Pragma("unroll") for (int n = 0; n < 2; ++n) \
            asm volatile("v_mfma_scale_f32_16x16x128_f8f6f4 %0, %1, %2, %0, %3, %3 op_sel_hi:[0,0,0]" : "+v"(acc[ai][bj][m][n]) : "v"(Bt##8[n]), "v"(At##8[m]), "v"(sc8)); }   \
        else { _Pragma("unroll") for (int m = 0; m < 4; ++m) _Pragma("unroll") for (int n = 0; n < 2; ++n) _Pragma("unroll") for (int k = 0; k < 2; ++k) \
            acc[ai][bj][m][n] = __builtin_amdgcn_mfma_f32_16x16x32_bf16(Bt[n][k], At[m][k], acc[ai][bj][m][n], 0, 0, 0); } \
        __builtin_amdgcn_s_setprio(0); } while (0)
#define PG8_WAIT_V(n) asm volatile("s_waitcnt vmcnt(" #n ")" ::: "memory")
#define PG8_WAIT_L(n) asm volatile("s_waitcnt lgkmcnt(" #n ")" ::: "memory")
#define PG8_BAR __builtin_amdgcn_s_barrier()
#define PG8_SCHED __builtin_amdgcn_sched_barrier(0)
    Unit cur, nxt; int ui = 0; int nsl = 0;
    if (!S.next(0, cur)) return;
    if constexpr (Epi::NTAB > 0) {
        Unit uu;
        for (int i = 0; i < 2048 / (256 * Epi::NTAB) && S.next(i, uu); ++i) if (tid < 256) E.fill_tab(tab + FTAB + i * 256 * Epi::NTAB, uu, tid);
        PG8_WAIT_L(0); }
    f32x4 acc[2][2][4][2];
#pragma unroll
    for (int a = 0; a < 2; ++a)
#pragma unroll
        for (int b = 0; b < 2; ++b)
#pragma unroll
            for (int m = 0; m < 4; ++m)
#pragma unroll
                for (int n = 0; n < 2; ++n) acc[a][b][m][n] = (f32x4){0.f, 0.f, 0.f, 0.f};
    const int sc8 = 0x7f7f7f7f;
    bf16x8 At[4][2], B0[2][2], B1[2][2]; v8i At8[4], B08[2], B18[2];
    const char* cA = Ab; const char* nA = Ab;
    if constexpr (Sched::GATHER) { if (tid < 256) { int sid; tab[tid] = S.rowoff(cur, tid, sid); tab[768 + tid] = (unsigned)sid; } PG8_WAIT_L(0); PG8_BAR; }
    else cA = S.aptr(cur, Ab);
    const char* cB = S.bptr(cur);
    const bool nx0 = false;
    PG8_STAGE_B(PG8_SB(0, 0), cB); PG8_STAGE_B(PG8_SB(0, 1), cB + hstep); PG8_STAGE_A(PG8_SA(0, 0), 0, 0, nx0); PG8_STAGE_A(PG8_SA(0, 1), 0, 1, nx0);
    if (wr == 1) PG8_BAR;
    PG8_WAIT_V(2); PG8_BAR;
    PG8_STAGE_B(PG8_SB(1, 0), cB + kstep); PG8_STAGE_A(PG8_SA(1, 0), kstep, 0, nx0); PG8_STAGE_B(PG8_SB(1, 1), cB + hstep + kstep);
    PG8_WAIT_V(6); PG8_BAR;
    for (;;) {
        const bool has_next = S.next(ui + 1, nxt);
        const char* nB = cB; nA = cA;
        if (has_next) { nB = S.bptr(nxt);
            if constexpr (Sched::GATHER) { if (tid < 256) { const int* lp = S.listptr(nxt, tid);
                asm volatile("global_load_dword %0, %1, off" : "=v"(nsl) : "v"(lp) : "memory"); } }
            else nA = S.aptr(nxt, Ab); }
        else { if constexpr (Sched::GATHER) { if (tid < 256) tab[(((ui + 1) & 1) << 8) + tid] = tab[((ui & 1) << 8) + tid]; } }
#pragma unroll 1
        for (int t = 0; t < nt; t += 2) {
            const bool last = (t == nt - 2);
            if constexpr (Sched::GATHER) { if (t == 2 && has_next && tid < 256) {
                asm volatile("s_waitcnt vmcnt(12)" : "+v"(nsl) :: "memory");
                tab[(((ui + 1) & 1) << 8) + tid] = S.off_of(nsl); tab[768 + (((ui + 1) & 1) << 8) + tid] = (unsigned)(tid < nxt.nv ? nsl : -1); } }
            const size_t ka1 = (size_t)(t + 1) * kstep;
            const size_t ka2 = last ? 0 : (size_t)(t + 2) * kstep; const char* b2 = last ? nB : cB + (size_t)(t + 2) * kstep;
            const size_t ka3 = ka2 + kstep; const char* b3 = b2 + kstep;
            if constexpr (Epi::MID) { if (t == nt / 2) {
#pragma unroll
                for (int a = 0; a < 2; ++a)
#pragma unroll
                    for (int m = 0; m < 4; ++m) { const float f = __uint_as_float(tab[FTAB + ui * 512 + a * HALF + wr * 64 + m * 16 + fr]);
#pragma unroll
                        for (int b = 0; b < 2; ++b)
#pragma unroll
                            for (int n = 0; n < 2; ++n) acc[a][b][m][n] = acc[a][b][m][n] * f; } } }
            PG8_LDB(B0, 0, 0); PG8_LDB(B1, 0, 1); PG8_SCHED; PG8_LDA(At, 0, 0); PG8_STAGE_A(PG8_SA(1, 1), ka1, 1, nx0);
            PG8_WAIT_V(8); PG8_WAIT_L(0); PG8_BAR; PG8_MMA(0, 0, At, B0); PG8_MMA(0, 1, At, B1); PG8_BAR; PG8_SCHED;
            PG8_LDA(At, 0, 1); PG8_STAGE_B(PG8_SB(0, 0), b2); PG8_STAGE_B(PG8_SB(0, 1), b2 + hstep); PG8_STAGE_A(PG8_SA(0, 0), ka2, 0, last);
            PG8_WAIT_V(8); PG8_WAIT_L(0); PG8_BAR; PG8_MMA(1, 0, At, B0); PG8_MMA(1, 1, At, B1); PG8_BAR; PG8_SCHED;
            PG8_LDB(B0, 1, 0); PG8_LDB(B1, 1, 1); PG8_SCHED; PG8_LDA(At, 1, 0); PG8_STAGE_A(PG8_SA(0, 1), ka2, 1, last);
            PG8_WAIT_V(8); PG8_WAIT_L(0); PG8_BAR; PG8_MMA(0, 0, At, B0); PG8_MMA(0, 1, At, B1); PG8_BAR; PG8_SCHED;
            PG8_LDA(At, 1, 1); PG8_STAGE_B(PG8_SB(1, 0), b3); PG8_STAGE_B(PG8_SB(1, 1), b3 + hstep); PG8_STAGE_A(PG8_SA(1, 0), ka3, 0, last);
            PG8_WAIT_V(8); PG8_WAIT_L(0); PG8_BAR; PG8_MMA(1, 0, At, B0); PG8_MMA(1, 1, At, B1); PG8_BAR; PG8_SCHED;
        }
        if (wr == 0) PG8_BAR;
        { int fr_e = fr, fq_e = fq; asm volatile("" : "+v"(fr_e), "+v"(fq_e));
          E(acc, cur, wr, wc, fr_e, fq_e, tab, ui); }
        if (!has_next) break;
#pragma unroll
        for (int a = 0; a < 2; ++a)
#pragma unroll
            for (int b = 0; b < 2; ++b)
#pragma unroll
                for (int m = 0; m < 4; ++m)
#pragma unroll
                    for (int n = 0; n < 2; ++n) acc[a][b][m][n] = (f32x4){0.f, 0.f, 0.f, 0.f};
        cur = nxt; cB = nB; cA = nA; ++ui;
        if (wr == 1) PG8_BAR;
    }
    PG8_WAIT_V(0);
    PG8_BAR;
#undef PG8_SA
#undef PG8_SB
#undef PG8_GLDS
#undef PG8_STAGE_A
#undef PG8_STAGE_B
#undef PG8_LDA
#undef PG8_LDB
#undef PG8_MMA
#undef PG8_WAIT_V
#undef PG8_WAIT_L
#undef PG8_BAR
#undef PG8_SCHED
}

struct DenseSched {
    static constexpr bool GATHER = false;
    int nM, nN, nwg, G, c, lda, K, xpn, has_main, lendN = 0, lendB = 0; const bf16* Bt; static constexpr int esz = 2;
    __device__ __forceinline__ void init(int M_, int N_, int G_, int c_, int lda_, int K_, const bf16* Bt_, int xpn_ = -1, int has_main_ = 1) { nM = M_ / BM; nN = N_ / BM; nwg = nM * nN; G = G_; c = c_; lda = lda_; K = K_; Bt = Bt_; xpn = xpn_; has_main = has_main_; }
    __device__ __forceinline__ bool next(int i_in, Unit& u) const { int i = i_in;
        if (xpn >= 0) { if (i == 0) { u.pm = nM; u.pn = xpn; u.e = 0; u.nv = 256; return true; } --i; }
        if (!has_main) return false;
        int cc = c;
        if (lendN > 0) { const int nmain = nwg / G; if (c < lendN && i >= nmain - 1) return false; if (i == nmain) { if (c < lendB || c >= lendB + lendN) return false; cc = c - lendB; i = nmain - 1; } }
        const long L = (long)i * G + cc; if (L >= nwg) return false;
        int wgid = (int)L; { const int q = nwg / 8, r = nwg % 8, xcd = wgid % 8, off = wgid / 8; wgid = (xcd < r ? xcd * (q + 1) : r * (q + 1) + (xcd - r) * q) + off; }
        const int nig = 8 * nN, gid = wgid / nig, fm = gid * 8, gsz = (nM - fm) < 8 ? (nM - fm) : 8;
        u.pm = fm + ((wgid % nig) % gsz); u.pn = (wgid % nig) / gsz; u.e = 0; u.nv = 256; return true;
    }
    __device__ __forceinline__ const char* bptr(const Unit& u) const { return (const char*)Bt + (size_t)u.pn * BM * K * 2; }
    __device__ __forceinline__ const char* aptr(const Unit& u, const char* Ab) const { return Ab + (size_t)u.pm * BM * lda * 2; }
    __device__ __forceinline__ unsigned rowoff(const Unit&, int) const { return 0u; }
};
struct MoeSched {
    static constexpr bool GATHER = true;
    const volatile LAS int* pre; const volatile LAS int* cn; const int* list; int G, c, npn, lda, K, tok; const void* Bt; size_t estride; int esz;
    __device__ __forceinline__ bool next(int i, Unit& u) const {
        const int L = i * G + c; const int tt = L / npn; if (tt >= __builtin_amdgcn_readfirstlane(pre[16])) return false;
        int e = 0;
#pragma unroll
        for (int k = 1; k < 16; ++k) e += (tt >= pre[k]) ? 1 : 0;
        u.e = __builtin_amdgcn_readfirstlane(e); u.pm = __builtin_amdgcn_readfirstlane(tt - pre[e]); u.pn = L % npn; u.nv = __builtin_amdgcn_readfirstlane(cn[e] - (tt - pre[e]) * BM); return true;
    }
    __device__ __forceinline__ const char* bptr(const Unit& u) const { return (const char*)Bt + ((size_t)u.e * estride + (size_t)u.pn * BM * K) * esz; }
    __device__ __forceinline__ const char* aptr(const Unit&, const char* Ab) const { return Ab; }
    __device__ __forceinline__ const int* listptr(const Unit& u, int r) const { const int idx = r < u.nv ? u.pm * BM + r : u.pm * BM; return list + (size_t)u.e * (2 * M) + idx; }
    __device__ __forceinline__ unsigned off_of(int slot) const { return (unsigned)(tok ? (slot >> 1) : slot) * (unsigned)(lda * esz); }
    __device__ __forceinline__ unsigned rowoff(const Unit& u, int r, int& sid) const {
        const int idx = r < u.nv ? u.pm * BM + r : u.pm * BM;
        const int slot = list[(size_t)u.e * (2 * M) + idx];
        sid = r < u.nv ? slot : -1;
        return (unsigned)(tok ? (slot >> 1) : slot) * (unsigned)(lda * esz);
    }
};

struct EpiA {
    static constexpr bool MID = false; static constexpr int NTAB = 0;
    bf16* U; float* ssq; float* sskv;
    __device__ __forceinline__ void operator()(const f32x4 (&acc)[2][2][4][2], const Unit& u, int wr, int wc, int fr, int fq, const volatile LAS unsigned* tab, int ui) const {
        const int row0 = u.pm * BM + wr * 64 + fr, col0 = u.pn * BM + wc * 32 + 8 * fq;
#pragma unroll
        for (int ai = 0; ai < 2; ++ai)
#pragma unroll
            for (int m = 0; m < 4; ++m) { bf16* rowp = U + (size_t)(row0 + ai * HALF + m * 16) * UC + col0;
#pragma unroll
                for (int bj = 0; bj < 2; ++bj) *(u32x4*)(rowp + bj * HALF) = pack8(acc[ai][bj][m][0], acc[ai][bj][m][1]); }
        if (u.pn <= 2) {
#pragma unroll
            for (int ai = 0; ai < 2; ++ai)
#pragma unroll
                for (int m = 0; m < 4; ++m) { float s = 0.f;
#pragma unroll
                    for (int bj = 0; bj < 2; ++bj)
#pragma unroll
                        for (int n = 0; n < 2; ++n) { const f32x4 x = acc[ai][bj][m][n]; s += (x[0] * x[0] + x[1] * x[1]) + (x[2] * x[2] + x[3] * x[3]); }
                    s += __shfl_xor(s, 16); s += __shfl_xor(s, 32);
                    const int row = row0 + ai * HALF + m * 16;
                    if (fq == 0) { if (u.pn < 2) ssq[row * 8 + u.pn * 4 + wc] = s; else sskv[row * 4 + wc] = s; } } }
    }
};
struct EpiQ {
    static constexpr bool MID = false; static constexpr int NTAB = 1;
    __device__ __forceinline__ void fill_tab(volatile LAS unsigned* t, const Unit& u, int r) const { const int row = u.pm * BM + r; const f32x4 q0 = *(const f32x4*)(ssq + row * 8), q1 = *(const f32x4*)(ssq + row * 8 + 4);
        t[r] = __float_as_uint(rsqrtf(((((q0[0] + q0[1]) + (q0[2] + q0[3])) + ((q1[0] + q1[1]) + (q1[2] + q1[3])))) * (1.f / QL) + EPS)); }
    unsigned char* QM; const float* ssq; const float* cosA; const float* sinA;
    static __device__ __forceinline__ u32x2 pk8(const f32x4 a, const f32x4 b) { u32x2 w; w.x = pack4_fp8(a[0], a[1], a[2], a[3]); w.y = pack4_fp8(b[0], b[1], b[2], b[3]); return w; }
    __device__ __forceinline__ void operator()(const f32x4 (&acc)[2][2][4][2], const Unit& u, int wr, int wc, int fr, int fq, const volatile LAS unsigned* tab, int ui) const {
        const int row0 = u.pm * BM + wr * 64 + fr;
        float rs[2][4];
#pragma unroll
        for (int ai = 0; ai < 2; ++ai)
#pragma unroll
            for (int m = 0; m < 4; ++m) rs[ai][m] = __uint_as_float(tab[FTAB + ui * 256 + ai * HALF + wr * 64 + m * 16 + fr]) * QSC_M;
#define EPIQ_ST16(PTR, AX, AY, BX, BY) { auto r0_ = __builtin_amdgcn_permlane16_swap(AX, BX, false, false); auto r1_ = __builtin_amdgcn_permlane16_swap(AY, BY, false, false); \
            u32x4 w_; w_.x = r0_[0]; w_.y = r1_[0]; w_.z = r0_[1]; w_.w = r1_[1]; *(u32x4*)(PTR) = w_; }
        const int fqe = 8 * (fq & ~1);
        if (u.pn < 4) {
#pragma unroll
            for (int ai = 0; ai < 2; ++ai)
#pragma unroll
                for (int mp = 0; mp < 4; mp += 2) { unsigned char* rowp = QM + (size_t)(row0 + ai * HALF + (mp + (fq & 1)) * 16) * 1536; const float ra = rs[ai][mp], rb = rs[ai][mp + 1];
#pragma unroll
                    for (int bj = 0; bj < 2; ++bj) { const u32x2 wa = pk8(acc[ai][bj][mp][0] * ra, acc[ai][bj][mp][1] * ra), wb = pk8(acc[ai][bj][mp + 1][0] * rb, acc[ai][bj][mp + 1][1] * rb);
                        EPIQ_ST16(rowp + (2 * u.pn + bj) * QKH + wc * 32 + fqe, wa.x, wa.y, wb.x, wb.y) } }
        } else {
            const int head = 4 * (u.pn - 4) + wc;
#pragma unroll
            for (int g2 = 0; g2 < 4; ++g2) { const int ai = g2 >> 1, mb = (g2 & 1) * 2;
                f32x4 cs[2][4];
#pragma unroll
                for (int mm = 0; mm < 2; ++mm) { const int t = (row0 + ai * HALF + (mb + mm) * 16) % T;
                    cs[mm][0] = *(const f32x4*)(cosA + t * 32 + 8 * fq); cs[mm][1] = *(const f32x4*)(cosA + t * 32 + 8 * fq + 4); cs[mm][2] = *(const f32x4*)(sinA + t * 32 + 8 * fq); cs[mm][3] = *(const f32x4*)(sinA + t * 32 + 8 * fq + 4); }
                u32x2 lo[2], hi2[2];
#pragma unroll
                for (int mm = 0; mm < 2; ++mm) { const int m = mb + mm; const float r = rs[ai][m];
                    const f32x4 a0 = acc[ai][0][m][0] * r, a1 = acc[ai][0][m][1] * r, b0 = acc[ai][1][m][0] * r, b1 = acc[ai][1][m][1] * r;
                    lo[mm] = pk8(a0 * cs[mm][0] - b0 * cs[mm][2], a1 * cs[mm][1] - b1 * cs[mm][3]);
                    hi2[mm] = pk8(a0 * cs[mm][2] + b0 * cs[mm][0], a1 * cs[mm][3] + b1 * cs[mm][1]); }
                unsigned char* rowp = QM + (size_t)(row0 + ai * HALF + (mb + (fq & 1)) * 16) * 1536 + head * QKH + NOPE + fqe;
                EPIQ_ST16(rowp, lo[0].x, lo[0].y, lo[1].x, lo[1].y)
                EPIQ_ST16(rowp + 32, hi2[0].x, hi2[0].y, hi2[1].x, hi2[1].y)
                asm volatile("" ::: "memory"); }
        }
#undef EPIQ_ST16
    }
};
struct EpiKV {
    static constexpr bool MID = false; static constexpr int NTAB = 1;
    __device__ __forceinline__ void fill_tab(volatile LAS unsigned* t, const Unit& u, int r) const { const f32x4 q0 = *(const f32x4*)(sskv + (u.pm * BM + r) * 4); t[r] = __float_as_uint(rsqrtf(((q0[0] + q0[1]) + (q0[2] + q0[3])) * (1.f / KVL) + EPS)); }
    bf16* KVB; unsigned char* KN8; const float* sskv;
    __device__ __forceinline__ void operator()(const f32x4 (&acc)[2][2][4][2], const Unit& u, int wr, int wc, int fr, int fq, const volatile LAS unsigned* tab, int ui) const {
        const int row0 = u.pm * BM + wr * 64 + fr, col0 = u.pn * BM + wc * 32 + 8 * fq;
        float rs[2][4];
#pragma unroll
        for (int ai = 0; ai < 2; ++ai)
#pragma unroll
            for (int m = 0; m < 4; ++m) rs[ai][m] = __uint_as_float(tab[FTAB + ui * 256 + ai * HALF + wr * 64 + m * 16 + fr]);
        if (u.pn < 4) {
            const int colp = u.pn * BM + wc * 32 + 8 * (fq & ~1);
#pragma unroll
            for (int ai = 0; ai < 2; ++ai)
#pragma unroll
                for (int mp = 0; mp < 4; mp += 2) { const size_t row = (size_t)(row0 + ai * HALF + (mp + (fq & 1)) * 16); const float ra = rs[ai][mp], rb = rs[ai][mp + 1];
#pragma unroll
                    for (int bj = 0; bj < 2; ++bj) { const f32x4 a0 = acc[ai][bj][mp][0] * ra, a1 = acc[ai][bj][mp][1] * ra, b0 = acc[ai][bj][mp + 1][0] * rb, b1 = acc[ai][bj][mp + 1][1] * rb;
                        const unsigned ax = pack4_fp8(a0[0], a0[1], a0[2], a0[3]), ay = pack4_fp8(a1[0], a1[1], a1[2], a1[3]), bx = pack4_fp8(b0[0], b0[1], b0[2], b0[3]), by = pack4_fp8(b1[0], b1[1], b1[2], b1[3]);
                        auto r0 = __builtin_amdgcn_permlane16_swap(ax, bx, false, false); auto r1 = __builtin_amdgcn_permlane16_swap(ay, by, false, false);
                        u32x4 w; w.x = r0[0]; w.y = r1[0]; w.z = r0[1]; w.w = r1[1];
                        *(u32x4*)(KN8 + row * 1024 + colp + bj * HALF) = w; } }
        } else {
#pragma unroll
            for (int ai = 0; ai < 2; ++ai)
#pragma unroll
                for (int m = 0; m < 4; ++m) { const size_t row = (size_t)(row0 + ai * HALF + m * 16); const float r = rs[ai][m];
#pragma unroll
                    for (int bj = 0; bj < 2; ++bj) *(u32x4*)(KVB + row * 2048 + col0 + bj * HALF) = pack8(acc[ai][bj][m][0] * r, acc[ai][bj][m][1] * r); }
        }
    }
};
struct EpiD {
    static constexpr bool MID = true; static constexpr int NTAB = 2;
    bf16* Z; const bf16* H; const float* sso;
    __device__ __forceinline__ float sum8(const float* p) const { const f32x4 a = *(const f32x4*)p, b = *(const f32x4*)(p + 4); return ((a[0] + a[1]) + (a[2] + a[3])) + ((b[0] + b[1]) + (b[2] + b[3])); }
    __device__ __forceinline__ void fill_tab(volatile LAS unsigned* t, const Unit& u, int r) const { const int row = u.pm * BM + r;
        const float va = sum8(sso + (size_t)row * 16) * (1.f / 1024) + EPS, vb = sum8(sso + (size_t)row * 16 + 8) * (1.f / 1024) + EPS;
        t[r] = __float_as_uint(rsqrtf(va) * sqrtf(vb)); t[256 + r] = __float_as_uint(rsqrtf(vb)); }
    __device__ __forceinline__ void operator()(const f32x4 (&acc)[2][2][4][2], const Unit& u, int wr, int wc, int fr, int fq, const volatile LAS unsigned* tab, int ui) const {
        const int row0 = u.pm * BM + wr * 64 + fr, col0 = u.pn * BM + wc * 32 + 8 * fq;
        float rs[2][4];
#pragma unroll
        for (int ai = 0; ai < 2; ++ai)
#pragma unroll
            for (int m = 0; m < 4; ++m) rs[ai][m] = __uint_as_float(tab[FTAB + ui * 512 + 256 + ai * HALF + wr * 64 + m * 16 + fr]);
        u32x4 hv[2][2][2];
#define EPID_LOAD(G2, BUF) { const int ai_ = (G2) >> 1, mb_ = ((G2) & 1) * 2; _Pragma("unroll") for (int mm = 0; mm < 2; ++mm) _Pragma("unroll") for (int bj = 0; bj < 2; ++bj) \
            hv[BUF][mm][bj] = *(const u32x4*)(H + (size_t)(row0 + ai_ * HALF + (mb_ + mm) * 16) * 2048 + col0 + bj * HALF); }
        EPID_LOAD(0, 0)
#pragma unroll
        for (int g2 = 0; g2 < 4; ++g2) { const int ai = g2 >> 1, mb = (g2 & 1) * 2;
            if (g2 + 1 < 4) { if (g2 & 1) EPID_LOAD(g2 + 1, 0) else EPID_LOAD(g2 + 1, 1) }
            __builtin_amdgcn_sched_barrier(0);
#pragma unroll
            for (int mm = 0; mm < 2; ++mm) { const int m = mb + mm; const size_t off = (size_t)(row0 + ai * HALF + m * 16) * 2048 + col0; const float r = rs[ai][m];
#pragma unroll
                for (int bj = 0; bj < 2; ++bj) { const u32x4 h = hv[g2 & 1][mm][bj];
                    const f32x4 h0 = {bf2f(h.x & 0xffffu), bf2f(h.x >> 16), bf2f(h.y & 0xffffu), bf2f(h.y >> 16)}, h1 = {bf2f(h.z & 0xffffu), bf2f(h.z >> 16), bf2f(h.w & 0xffffu), bf2f(h.w >> 16)};
                    *(u32x4*)(Z + off + bj * HALF) = pack8(h0 * ALPHA + acc[ai][bj][m][0] * r, h1 * ALPHA + acc[ai][bj][m][1] * r); } }
            __builtin_amdgcn_sched_barrier(0); }
#undef EPID_LOAD
    }
};
struct EpiGU {
    static constexpr bool MID = false; static constexpr int NTAB = 0;
    bf16* HE; const int* list; float inscale; float oscale8;
    __device__ __forceinline__ void operator()(const f32x4 (&acc)[2][2][4][2], const Unit& u, int wr, int wc, int fr, int fq, const volatile LAS unsigned* tab, int ui) const {
        for (int prep = 0; prep < 1 + ((PROBE_MODE >> 3) & 1); ++prep) { asm volatile("" ::: "memory");
        if (oscale8 > 0.f) {
            const int colp = u.pn * HALF + wc * 32 + 8 * (fq & ~1);
#pragma unroll
            for (int ai = 0; ai < 2; ++ai)
#pragma unroll
                for (int mp = 0; mp < 4; mp += 2) { const int sl = (int)tab[768 + ((ui & 1) << 8) + ai * HALF + wr * 64 + (mp + (fq & 1)) * 16 + fr];
                    unsigned pk[2][2];
#pragma unroll
                    for (int mm = 0; mm < 2; ++mm)
#pragma unroll
                        for (int n = 0; n < 2; ++n) { float o[4];
#pragma unroll
                            for (int i = 0; i < 4; ++i) { const float g = acc[ai][0][mp + mm][n][i] * inscale, uu = acc[ai][1][mp + mm][n][i] * inscale; o[i] = g * __builtin_amdgcn_rcpf(1.f + __expf(-g)) * uu * oscale8; }
                            pk[mm][n] = pack4_fp8(o[0], o[1], o[2], o[3]); }
                    auto r0 = __builtin_amdgcn_permlane16_swap(pk[0][0], pk[1][0], false, false); auto r1 = __builtin_amdgcn_permlane16_swap(pk[0][1], pk[1][1], false, false);
                    u32x4 w; w.x = r0[0]; w.y = r1[0]; w.z = r0[1]; w.w = r1[1];
                    if (sl >= 0) *(u32x4*)((unsigned char*)HE + (size_t)sl * EFF + colp) = w;
                    __builtin_amdgcn_sched_barrier(0); }
        } else {
#pragma unroll
        for (int ai = 0; ai < 2; ++ai)
#pragma unroll
            for (int m = 0; m < 4; ++m) { const int sl = (int)tab[768 + ((ui & 1) << 8) + ai * HALF + wr * 64 + m * 16 + fr]; if (sl >= 0) { f32x4 o[2];
#pragma unroll
                for (int n = 0; n < 2; ++n)
#pragma unroll
                    for (int i = 0; i < 4; ++i) { const float g = acc[ai][0][m][n][i] * inscale, uu = acc[ai][1][m][n][i] * inscale; o[n][i] = g * __builtin_amdgcn_rcpf(1.f + __expf(-g)) * uu; }
                *(u32x4*)(HE + (size_t)sl * EFF + u.pn * HALF + wc * 32 + 8 * fq) = pack8(o[0], o[1]); } }
        }
        }
    }
};
struct EpiDown {
    static constexpr bool MID = false; static constexpr int NTAB = 0;
    bf16* Y; const int* list; float inscale; float oscale8;
    __device__ __forceinline__ void operator()(const f32x4 (&acc)[2][2][4][2], const Unit& u, int wr, int wc, int fr, int fq, const volatile LAS unsigned* tab, int ui) const {
        const int col0 = u.pn * BM + wc * 32 + 8 * fq;
        for (int prep = 0; prep < 1 + ((PROBE_MODE >> 2) & 1); ++prep) { asm volatile("" ::: "memory");
        if (oscale8 > 0.f) {
            const float sc = inscale * oscale8; const int colp = u.pn * BM + wc * 32 + 8 * (fq & ~1);
#pragma unroll
            for (int ai = 0; ai < 2; ++ai)
#pragma unroll
                for (int mp = 0; mp < 4; mp += 2) { const int sl = (int)tab[768 + ((ui & 1) << 8) + ai * HALF + wr * 64 + (mp + (fq & 1)) * 16 + fr];
#pragma unroll
                    for (int bj = 0; bj < 2; ++bj) {
                        const f32x4 a0 = acc[ai][bj][mp][0] * sc, a1 = acc[ai][bj][mp][1] * sc, b0 = acc[ai][bj][mp + 1][0] * sc, b1 = acc[ai][bj][mp + 1][1] * sc;
                        const unsigned ax = pack4_fp8(a0[0], a0[1], a0[2], a0[3]), ay = pack4_fp8(a1[0], a1[1], a1[2], a1[3]), bx = pack4_fp8(b0[0], b0[1], b0[2], b0[3]), by = pack4_fp8(b1[0], b1[1], b1[2], b1[3]);
                        auto r0 = __builtin_amdgcn_permlane16_swap(ax, bx, false, false); auto r1 = __builtin_amdgcn_permlane16_swap(ay, by, false, false);
                        u32x4 w; w.x = r0[0]; w.y = r1[0]; w.z = r0[1]; w.w = r1[1];
                        if (sl >= 0) *(u32x4*)((unsigned char*)Y + (size_t)sl * DM + colp + bj * HALF) = w; }
                    __builtin_amdgcn_sched_barrier(0); }
        } else {
#pragma unroll
        for (int ai = 0; ai < 2; ++ai)
#pragma unroll
            for (int m = 0; m < 4; ++m) { const int sl = (int)tab[768 + ((ui & 1) << 8) + ai * HALF + wr * 64 + m * 16 + fr]; if (sl >= 0) { bf16* rowp = Y + (size_t)sl * DM + col0;
#pragma unroll
                    for (int bj = 0; bj < 2; ++bj) *(u32x4*)(rowp + bj * HALF) = pack8(acc[ai][bj][m][0] * inscale, acc[ai][bj][m][1] * inscale); } }
        }
        }
    }
};
}


namespace att {
using s16x4 = __attribute__((ext_vector_type(4))) short;
constexpr int NW = 8, QBLK = 32, KVBLK = 64, NT = (T + KVBLK - 1) / KVBLK;
static_assert(NT % 2 == 1 && T - (NT - 1) * KVBLK == 16, "tail handling below is written for an odd tile count with a 16-key last tile");
constexpr int SHM_V = 16384, SHM_K = 8192, SHM_K2 = 4096;
constexpr int OFF_V = 0, OFF_K = 2 * SHM_V, OFF_K2 = OFF_K + 2 * SHM_K, OFF_WS = OFF_K2 + 2 * SHM_K2, ATT_LDS = OFF_WS + NW * 256;
constexpr int OST_PITCH = 272, OST_WAVE = 32 * OST_PITCH, OFF_OST = 61440;
static_assert(ATT_LDS <= OFF_OST && OFF_OST + 8 * OST_WAVE <= RING_BYTES, "attention LDS map");
static_assert(ATT_LDS <= RING_BYTES, "attention LDS");
#define KSWZ(row, colB) ((row) * 256 + ((colB) ^ (((row) & 7) << 4)))
#define KSWZ2(row, colB) ((row) * 128 + ((colB) ^ ((((row) >> 1) & 7) << 4)))
#define SBAR() __builtin_amdgcn_sched_barrier(0)
__device__ __forceinline__ unsigned cvtpk(float lo, float hi) { unsigned r; asm volatile("v_cvt_pk_bf16_f32 %0, %1, %2" : "=v"(r) : "v"(lo), "v"(hi)); return r; }
__device__ __forceinline__ void partialSM(f32x16& p0, f32x16& p1, float& m_reg, float& mn, float& alpha, float C, float thr) {
  float pmax = p0[0];
#pragma unroll
  for (int r = 1; r < 16; ++r) pmax = fmaxf(pmax, p0[r]);
#pragma unroll
  for (int r = 0; r < 16; ++r) pmax = fmaxf(pmax, p1[r]);
  { auto rr = __builtin_amdgcn_permlane32_swap(__float_as_uint(pmax), __float_as_uint(pmax), false, false);
    pmax = fmaxf(__uint_as_float(rr[0]), __uint_as_float(rr[1])); }
  if (__builtin_expect(__all(pmax - m_reg <= thr), 1)) { mn = m_reg; alpha = 1.f; }
  else { mn = fmaxf(m_reg, pmax); alpha = __builtin_amdgcn_exp2f((m_reg - mn) * C); m_reg = mn; }
  const float mnC = -mn * C;
#pragma unroll
  for (int r = 0; r < 16; ++r) p0[r] = fmaf(p0[r], C, mnC);
#pragma unroll
  for (int r = 0; r < 16; ++r) p1[r] = fmaf(p1[r], C, mnC);
#pragma unroll
  for (int r = 0; r < 16; ++r) p0[r] = __builtin_amdgcn_exp2f(p0[r]);
}
__device__ __forceinline__ void finishSM(f32x16& p0, f32x16& p1, float alpha, float& l_reg, bf16x8& pa0, bf16x8& pa1, bf16x8& pa2, bf16x8& pa3) {
#pragma unroll
  for (int r = 0; r < 16; ++r) p1[r] = __builtin_amdgcn_exp2f(p1[r]);
  float ps = 0;
#pragma unroll
  for (int r = 0; r < 16; ++r) ps += p0[r];
#pragma unroll
  for (int r = 0; r < 16; ++r) ps += p1[r];
  { auto rr = __builtin_amdgcn_permlane32_swap(__float_as_uint(ps), __float_as_uint(ps), false, false);
    ps = __uint_as_float(rr[0]) + __uint_as_float(rr[1]); }
  l_reg = l_reg * alpha + ps;
#define PK4(P, BASE, OUT) do { unsigned a0 = cvtpk(P[BASE + 0], P[BASE + 1]), a1 = cvtpk(P[BASE + 2], P[BASE + 3]);   \
    unsigned b0 = cvtpk(P[BASE + 4], P[BASE + 5]), b1 = cvtpk(P[BASE + 6], P[BASE + 7]);                              \
    auto r0 = __builtin_amdgcn_permlane32_swap(a0, b0, false, false); auto r1 = __builtin_amdgcn_permlane32_swap(a1, b1, false, false); \
    u32x4 w = {r0[0], r1[0], r0[1], r1[1]}; OUT = __builtin_bit_cast(bf16x8, w); } while (0)
  PK4(p0, 0, pa0); PK4(p0, 8, pa1); PK4(p1, 0, pa2); PK4(p1, 8, pa3);
#undef PK4
}
typedef int v8i __attribute__((ext_vector_type(8)));
typedef int v4i __attribute__((ext_vector_type(4)));
__device__ __forceinline__ v8i ld32(const LAS unsigned char* p, int a) { const v4i x = *(const LAS v4i*)(p + a), y = *(const LAS v4i*)(p + (a ^ 16)); return __builtin_shufflevector(x, y, 0, 1, 2, 3, 4, 5, 6, 7); }
template <bool MLA>
__device__ __forceinline__ void qkt(f32x16& p0, f32x16& p1, const LAS unsigned char* Ks, const LAS unsigned char* K2s, const v8i* qr8, int r32, int hi, const f32x16 init = f32x16{}) {
  p0 = init; p1 = init;
  const int sw = (r32 >> 1) & 7, rb = r32 * 128;
#pragma unroll
  for (int st = 0; st < 2; ++st) { const int a = rb + (((4 * st + 2 * hi) ^ sw) * 16);
    const v8i k0 = ld32(Ks, a), k1 = ld32(Ks, a + 32 * 128);
    p0 = __builtin_amdgcn_mfma_scale_f32_32x32x64_f8f6f4(k0, qr8[st], p0, 0, 0, 0, 0x7f7f7f7f, 0, QSCALE_E8);
    p1 = __builtin_amdgcn_mfma_scale_f32_32x32x64_f8f6f4(k1, qr8[st], p1, 0, 0, 0, 0x7f7f7f7f, 0, QSCALE_E8); }
  if constexpr (MLA) { const int a = r32 * 64 + (((2 * hi) ^ ((r32 >> 2) & 3)) * 16);
    const v8i k0 = ld32(K2s, a), k1 = ld32(K2s, a + 32 * 64);
    p0 = __builtin_amdgcn_mfma_scale_f32_32x32x64_f8f6f4(k0, qr8[2], p0, 0, 0, 0, 0x7f7f7f7f, 0, QSCALE_E8);
    p1 = __builtin_amdgcn_mfma_scale_f32_32x32x64_f8f6f4(k1, qr8[2], p1, 0, 0, 0, 0x7f7f7f7f, 0, QSCALE_E8); }
}
__device__ __forceinline__ int v_st(int k, int c) { const int kk = (k & ~0xC) | ((k & 4) << 1) | ((k & 8) >> 1); return ((kk >> 3) * 4 + (c >> 5)) * 512 + ((kk & 7) * 32 + (c & 31)) * 2; }
__device__ __forceinline__ int v_rd_base(int lane) { return ((lane & 3) << 3) | (((lane >> 2) & 3) << 6) | (((lane >> 4) & 1) << 5) | (((lane >> 5) & 1) << 8); }
constexpr int v_rd_off(int d0, int ks, int half) { return d0 * 512 + ks * 4096 + half * 2048; }
template <int OFF> __device__ __forceinline__ s16x4 tr_read(int vb) {
  s16x4 r; asm volatile("ds_read_b64_tr_b16 %0, %1 offset:%2" : "=&v"(r) : "v"(vb), "i"(OFF) : "memory"); return r;
}
template <int D0> __device__ __forceinline__ void pv_one(f32x16& od, int vb, bf16x8 pa0, bf16x8 pa1, bf16x8 pa2, bf16x8 pa3) {
  const s16x4 l0 = tr_read<v_rd_off(D0, 0, 0)>(vb), h0 = tr_read<v_rd_off(D0, 0, 1)>(vb), l1 = tr_read<v_rd_off(D0, 1, 0)>(vb), h1 = tr_read<v_rd_off(D0, 1, 1)>(vb);
  const s16x4 l2 = tr_read<v_rd_off(D0, 2, 0)>(vb), h2 = tr_read<v_rd_off(D0, 2, 1)>(vb), l3 = tr_read<v_rd_off(D0, 3, 0)>(vb), h3 = tr_read<v_rd_off(D0, 3, 1)>(vb);
  asm volatile("s_waitcnt lgkmcnt(0)" ::: "memory"); SBAR();
#define PK(L, H) (bf16x8){L[0], L[1], L[2], L[3], H[0], H[1], H[2], H[3]}
  od = __builtin_amdgcn_mfma_f32_32x32x16_bf16(pa0, PK(l0, h0), od, 0, 0, 0);
  od = __builtin_amdgcn_mfma_f32_32x32x16_bf16(pa1, PK(l1, h1), od, 0, 0, 0);
  od = __builtin_amdgcn_mfma_f32_32x32x16_bf16(pa2, PK(l2, h2), od, 0, 0, 0);
  od = __builtin_amdgcn_mfma_f32_32x32x16_bf16(pa3, PK(l3, h3), od, 0, 0, 0);
#undef PK
}
constexpr float SM_BIG = 2048.f;
__device__ __forceinline__ void expSM(f32x16& p0) {
#pragma unroll
  for (int r = 0; r < 16; ++r) p0[r] = __builtin_amdgcn_exp2f(p0[r]);
}
__device__ __forceinline__ float xhalf_max(float v) { auto rr = __builtin_amdgcn_permlane32_swap(__float_as_uint(v), __float_as_uint(v), false, false); return fmaxf(__uint_as_float(rr[0]), __uint_as_float(rr[1])); }
__device__ __forceinline__ float xhalf_sum(float v) { auto rr = __builtin_amdgcn_permlane32_swap(__float_as_uint(v), __float_as_uint(v), false, false); return __uint_as_float(rr[0]) + __uint_as_float(rr[1]); }
__device__ __forceinline__ void finishSM2(f32x16& p0, f32x16& p1, float& dm, float& l_reg, float& alpha, bool& ovf, bf16x8& pa0, bf16x8& pa1, bf16x8& pa2, bf16x8& pa3) {
#pragma unroll
  for (int r = 0; r < 16; ++r) p1[r] = __builtin_amdgcn_exp2f(p1[r]);
  float ps = 0;
#pragma unroll
  for (int r = 0; r < 16; ++r) ps += p0[r];
#pragma unroll
  for (int r = 0; r < 16; ++r) ps += p1[r];
  ps = xhalf_sum(ps);
  alpha = 1.f; dm = 0.f;
  if (__builtin_expect(!__all(ps <= (SM_TEST == 1 ? 0.5f : SM_BIG)), 0)) {
    asm volatile("");
    float pmax = p0[0];
#pragma unroll
    for (int r = 1; r < 16; ++r) pmax = fmaxf(pmax, p0[r]);
#pragma unroll
    for (int r = 0; r < 16; ++r) pmax = fmaxf(pmax, p1[r]);
    pmax = xhalf_max(pmax);
    if (!(pmax < 1e30f)) ovf = true;
    const bool up = pmax > 1.f; const float sc = up ? __builtin_amdgcn_rcpf(pmax) : 1.f;
    alpha = sc; dm = up ? __builtin_amdgcn_logf(pmax) : 0.f;
#pragma unroll
    for (int r = 0; r < 16; ++r) { p0[r] *= sc; p1[r] *= sc; }
    ps *= sc;
  }
  l_reg = l_reg * alpha + ps;
#define PK4(P, BASE, OUT) do { unsigned a0 = cvtpk(P[BASE + 0], P[BASE + 1]), a1 = cvtpk(P[BASE + 2], P[BASE + 3]);   \
    unsigned b0 = cvtpk(P[BASE + 4], P[BASE + 5]), b1 = cvtpk(P[BASE + 6], P[BASE + 7]);                              \
    auto r0 = __builtin_amdgcn_permlane32_swap(a0, b0, false, false); auto r1 = __builtin_amdgcn_permlane32_swap(a1, b1, false, false); \
    u32x4 w = {r0[0], r1[0], r0[1], r1[1]}; OUT = __builtin_bit_cast(bf16x8, w); } while (0)
  PK4(p0, 0, pa0); PK4(p0, 8, pa1); PK4(p1, 0, pa2); PK4(p1, 8, pa3);
#undef PK4
}
#define PVR(S, D0, VB) const s16x4 S##l0 = tr_read<v_rd_off(D0, 0, 0)>(VB), S##h0 = tr_read<v_rd_off(D0, 0, 1)>(VB), S##l1 = tr_read<v_rd_off(D0, 1, 0)>(VB), S##h1 = tr_read<v_rd_off(D0, 1, 1)>(VB), \
                                    S##l2 = tr_read<v_rd_off(D0, 2, 0)>(VB), S##h2 = tr_read<v_rd_off(D0, 2, 1)>(VB), S##l3 = tr_read<v_rd_off(D0, 3, 0)>(VB), S##h3 = tr_read<v_rd_off(D0, 3, 1)>(VB);
#define PVK(L, H) (bf16x8){L[0], L[1], L[2], L[3], H[0], H[1], H[2], H[3]}
#define PVM(S, OD) OD = __builtin_amdgcn_mfma_f32_32x32x16_bf16(pa0, PVK(S##l0, S##h0), OD, 0, 0, 0); OD = __builtin_amdgcn_mfma_f32_32x32x16_bf16(pa1, PVK(S##l1, S##h1), OD, 0, 0, 0); \
                   OD = __builtin_amdgcn_mfma_f32_32x32x16_bf16(pa2, PVK(S##l2, S##h2), OD, 0, 0, 0); OD = __builtin_amdgcn_mfma_f32_32x32x16_bf16(pa3, PVK(S##l3, S##h3), OD, 0, 0, 0);
#define PV_BEGIN(VB) PVR(a, 0, VB) SBAR();
#define EXP4(P, B0) do { P[B0] = __builtin_amdgcn_exp2f(P[B0]); P[B0 + 1] = __builtin_amdgcn_exp2f(P[B0 + 1]); P[B0 + 2] = __builtin_amdgcn_exp2f(P[B0 + 2]); P[B0 + 3] = __builtin_amdgcn_exp2f(P[B0 + 3]); } while (0)
#define PV_REST(VB) PV_REST_X(VB, PV_NOX, 0)
#define PV_NOX(P, B0) do { } while (0)
#define PV_REST_X(VB, X, XP) \
  PVR(b, 1, VB) \
  asm volatile("s_waitcnt lgkmcnt(8)" ::: "memory"); SBAR(); \
  PVM(a, o[0]) X(XP, 0); SBAR(); \
  PVR(c, 2, VB) \
  asm volatile("s_waitcnt lgkmcnt(8)" ::: "memory"); SBAR(); \
  PVM(b, o[1]) X(XP, 4); SBAR(); \
  PVR(d, 3, VB) \
  asm volatile("s_waitcnt lgkmcnt(8)" ::: "memory"); SBAR(); \
  PVM(c, o[2]) X(XP, 8); SBAR(); \
  asm volatile("s_waitcnt lgkmcnt(0)" ::: "memory"); SBAR(); \
  PVM(d, o[3]) X(XP, 12);
struct UnitArgs { const unsigned char* Q; int ldq; const unsigned char* K1; int ldk1; const unsigned char* K2; int ldk2; const bf16* V; int ldv; bf16* O; float* sso; int nq; float scale; };
template <bool MLA, bool SAFE>
__device__ __forceinline__ bool attn_unit(const UnitArgs& A, LAS unsigned char* lds, int wave_in, int fslot) {
  int tid = wave_in * 64 + lane_id(); asm volatile("" : "+v"(tid));
  const int wid = __builtin_amdgcn_readfirstlane(tid >> 6), lane = tid & 63, r32 = lane & 31, hi = lane >> 5;
  LAS unsigned char* V_lds = lds + OFF_V; LAS unsigned char* K_lds = lds + OFF_K; LAS unsigned char* K2_lds = lds + OFF_K2;
  LAS float* wsf = (LAS float*)(lds + OFF_WS) + wid * 64; LAS float* li_l = wsf; LAS float* al_l = wsf + 32;
  const bool wact = wid * QBLK < A.nq;
  volatile LAS unsigned* oflag = (volatile LAS unsigned*)(lds + ATT_LDS) + fslot;
  if (!SAFE && tid == 0) *oflag = 0u;
  bool ovf = false;
  const int sr = tid >> 4, sc = (tid & 15) * 8, vst0 = v_st(sr, sc), vst1 = v_st(32 + sr, sc);
  const int kr = tid >> 3, kc = tid & 7, kst = kr * 128 + ((kc ^ ((kr >> 1) & 7)) * 16);
  const int k2r = (tid & 255) >> 2, k2c = tid & 3, k2st = k2r * 64 + ((k2c ^ ((k2r >> 2) & 3)) * 16);
  const bool k2w = tid < 256;
  unsigned vo = (unsigned)(sr * A.ldv + sc) * 2u, ko = (unsigned)(kr * A.ldk1 + kc * 16), k2o = (unsigned)(k2r * A.ldk2 + k2c * 16);
  const unsigned v32 = 64u * (unsigned)A.ldv, k64 = 64u * (unsigned)A.ldk1, k2s64 = 64u * (unsigned)A.ldk2;
  const char* Vb = (const char*)A.V; const char* K1b = (const char*)A.K1; const char* K2b = (const char*)A.K2;
  bf16x8 vs0, vs1; v4i ks0, k2s;
#define SLOAD() do { vs0 = *(const bf16x8*)(Vb + vo); vs1 = *(const bf16x8*)(Vb + (vo + v32)); ks0 = *(const v4i*)(K1b + ko); vo += 2 * v32; ko += k64; \
    if (MLA) { if (k2w) k2s = *(const v4i*)(K2b + k2o); k2o += k2s64; } } while (0)
#define SWRITE(b) do { asm volatile("s_waitcnt vmcnt(0)" ::: "memory"); *(LAS bf16x8*)(V_lds + (b) * SHM_V + vst0) = vs0; *(LAS bf16x8*)(V_lds + (b) * SHM_V + vst1) = vs1; \
    *(LAS v4i*)(K_lds + (b) * SHM_K + kst) = ks0; \
    if (MLA) { if (k2w) *(LAS v4i*)(K2_lds + (b) * SHM_K2 + k2st) = k2s; } } while (0)
  if (!wact) {
    SLOAD(); SWRITE(0); __syncthreads();
    SLOAD(); SWRITE(1); __syncthreads();
#pragma unroll 1
    for (int j = 1; j + 1 < NT; j += 2) {
      SLOAD(); __syncthreads(); SWRITE(0); __syncthreads();
      if (j + 2 < NT) SLOAD(); __syncthreads(); if (j + 2 < NT) SWRITE(1); __syncthreads();
    }
    __syncthreads();
  } else {
  const float C = 1.f, thr = 8.f * 1.4426950408889634f;
  float m_reg = -1e30f, l_reg = 0; f32x16 o[4] = {}; v8i qr8[MLA ? 3 : 2];
  { int qrow = wid * QBLK + r32; qrow = qrow < A.nq ? qrow : A.nq - 1;
    const unsigned char* Qw = A.Q + (size_t)qrow * A.ldq + hi * 32;
#pragma unroll
    for (int st = 0; st < (MLA ? 3 : 2); ++st) { const v4i x = *(const v4i*)(Qw + st * 64), y = *(const v4i*)(Qw + st * 64 + 16); qr8[st] = __builtin_shufflevector(x, y, 0, 1, 2, 3, 4, 5, 6, 7); } }
  const int vb0 = (int)(unsigned)(size_t)V_lds + v_rd_base(lane);
#define RESC(a) do { if (__any((a) < 1.f)) { if (hi == 0) al_l[r32] = (a); asm volatile("s_waitcnt lgkmcnt(0)" ::: "memory"); \
    _Pragma("unroll") for (int d = 0; d < 4; ++d) _Pragma("unroll") for (int r = 0; r < 16; ++r) o[d][r] *= al_l[crow(r, hi)]; } } while (0)
  f32x16 pA0, pA1, pB0, pB1; float mnA, mnB, alA = 1.f, alB = 1.f; bf16x8 pa0, pa1, pa2, pa3;
  SLOAD(); SWRITE(0); __syncthreads();
  qkt<MLA>(pA0, pA1, K_lds, K2_lds, qr8, r32, hi); partialSM(pA0, pA1, m_reg, mnA, alA, C, thr);
  SLOAD(); SWRITE(1); __syncthreads();
  f32x16 negm; float dm = 0.f;
  if constexpr (!SAFE) {
#pragma unroll
    for (int r = 0; r < 16; ++r) negm[r] = -m_reg; }
#define BUMP(P0, P1) do { if (__any(dm != 0.f)) { asm volatile(""); _Pragma("unroll") for (int r = 0; r < 16; ++r) { negm[r] -= dm; P0[r] -= dm; P1[r] -= dm; } } } while (0)
#pragma unroll 1
  for (int j = 1; j + 1 < NT; j += 2) {
    SLOAD(); SBAR();
    if constexpr (SAFE) qkt<MLA>(pB0, pB1, K_lds + SHM_K, K2_lds + SHM_K2, qr8, r32, hi); else qkt<MLA>(pB0, pB1, K_lds + SHM_K, K2_lds + SHM_K2, qr8, r32, hi, negm);
    if constexpr (SAFE) {
    { PV_BEGIN(vb0) finishSM(pA0, pA1, alA, l_reg, pa0, pa1, pa2, pa3); SBAR();
      PV_REST(vb0); } partialSM(pB0, pB1, m_reg, mnB, alB, C, thr);
    __syncthreads(); SWRITE(0);
    RESC(alB); __syncthreads();
    } else {
    { finishSM2(pA0, pA1, dm, l_reg, alA, ovf, pa0, pa1, pa2, pa3); BUMP(pB0, pB1); RESC(alA); SBAR();
      PV_BEGIN(vb0) PV_REST_X(vb0, EXP4, pB0); }
    __syncthreads(); SWRITE(0);
    __syncthreads();
    }
    if (j + 2 < NT) SLOAD(); SBAR();
    if constexpr (SAFE) qkt<MLA>(pA0, pA1, K_lds, K2_lds, qr8, r32, hi); else qkt<MLA>(pA0, pA1, K_lds, K2_lds, qr8, r32, hi, negm);
    if (j + 1 == NT - 1) {
      asm volatile("");
#pragma unroll
      for (int r = 8; r < 16; ++r) pA0[r] = -1e30f;
#pragma unroll
      for (int r = 0; r < 16; ++r) pA1[r] = -1e30f; }
    if constexpr (SAFE) {
    { PV_BEGIN(vb0 + SHM_V) finishSM(pB0, pB1, alB, l_reg, pa0, pa1, pa2, pa3); SBAR();
      PV_REST(vb0 + SHM_V); } partialSM(pA0, pA1, m_reg, mnA, alA, C, thr);
    __syncthreads(); if (j + 2 < NT) SWRITE(1);
    RESC(alA); __syncthreads();
    } else {
    { finishSM2(pB0, pB1, dm, l_reg, alB, ovf, pa0, pa1, pa2, pa3); BUMP(pA0, pA1); RESC(alB); SBAR();
      PV_BEGIN(vb0 + SHM_V) PV_REST_X(vb0 + SHM_V, EXP4, pA0); }
    __syncthreads(); if (j + 2 < NT) SWRITE(1);
    __syncthreads();
    }
  }
  {
    if constexpr (SAFE) { PV_BEGIN(vb0) finishSM(pA0, pA1, alA, l_reg, pa0, pa1, pa2, pa3); SBAR();
      PV_REST(vb0); }
    else { finishSM2(pA0, pA1, dm, l_reg, alA, ovf, pa0, pa1, pa2, pa3); RESC(alA); SBAR();
      PV_BEGIN(vb0) PV_REST(vb0); }
    if (!SAFE && (__any(ovf) || SM_TEST == 2) && lane == 0) *oflag = 1u;
    if (hi == 0) li_l[r32] = l_reg; asm volatile("s_waitcnt lgkmcnt(0)" ::: "memory");
    int r32e = r32, hie = hi; asm volatile("" : "+v"(r32e), "+v"(hie));
    LAS unsigned char* ost = lds + OFF_OST + wid * OST_WAVE;
#pragma unroll
    for (int r = 0; r < 16; ++r) { const int orow = crow(r, hie); const bool ok = wid * QBLK + orow < A.nq; float s = 0.f; const float rl = __builtin_amdgcn_rcpf(li_l[orow]);
#pragma unroll
      for (int d0 = 0; d0 < 4; ++d0) { const float v = o[d0][r] * rl; s += v * v; *(LAS bf16*)(ost + orow * OST_PITCH + (d0 * 32 + r32e) * 2) = (bf16)cvtpk(v, v); }
      s += __shfl_xor(s, 1); s += __shfl_xor(s, 2); s += __shfl_xor(s, 4); s += __shfl_xor(s, 8); s += __shfl_xor(s, 16);
      if (ok && r32e == 0) A.sso[(size_t)(wid * QBLK + orow) * 16] = s; }
    asm volatile("s_waitcnt lgkmcnt(0)" ::: "memory");
    { const int lane_e = r32e + 32 * hie; bf16* Ob = A.O + (size_t)(wid * QBLK) * 2048 + (lane_e & 15) * 8;
#pragma unroll
      for (int i = 0; i < 8; ++i) { const int orow = 4 * i + (lane_e >> 4); const u32x4 w = *(const LAS u32x4*)(ost + orow * OST_PITCH + (lane_e & 15) * 16);
        if (wid * QBLK + orow < A.nq) *(u32x4*)(Ob + (size_t)orow * 2048) = w; } }
  }
  __syncthreads();
#undef RESC
#undef BUMP
  }
#undef SLOAD
#undef SWRITE
  return SAFE ? false : (*oflag != 0u);
}
__device__ __forceinline__ void attn_phase(LAS unsigned char* lds, int wave_in, int G, int vcu, const unsigned char* QM8, const unsigned char* GQ8, const unsigned char* GK8, const unsigned char* KN8, const unsigned char* KR8, const bf16* KVB, const bf16* U, bf16* OA, float* sso) {
  for (int i = 0;; ++i) {
    const int id = i * G + vcu; if (id >= 9 * 256) break;
    const int r = id >> 8, v = id & 255, b = v >> 4, c = v & 15;
    int head16, qt;
    if (r < 4) { head16 = c >> 1; qt = (c & 1) * 4 + r; } else if (r < 8) { head16 = 8 + (c >> 1); qt = (c & 1) * 4 + r - 4; } else { head16 = c; qt = 8; }
    const bool mla = head16 < 8; const int h = head16 & 7; const size_t row0 = (size_t)b * T, q0 = row0 + (size_t)qt * 256;
    UnitArgs A;
    A.nq = (T - qt * 256) < 256 ? (T - qt * 256) : 256; A.scale = mla ? MLA_SCALE : GQA_SCALE;
    A.Q = mla ? QM8 + q0 * 1536 + h * QKH : GQ8 + q0 * 1024 + h * GD; A.ldq = mla ? 1536 : 1024;
    A.K1 = mla ? KN8 + row0 * 1024 + h * 128 : GK8 + row0 * 256 + (h >> 2) * GD; A.ldk1 = mla ? 1024 : 256;
    A.K2 = KR8 + row0 * 64; A.ldk2 = 64;
    A.V = mla ? KVB + row0 * 2048 + 1024 + h * 128 : U + row0 * UC + U_GV + (h >> 2) * GD; A.ldv = mla ? 2048 : UC;
    A.O = OA + q0 * 2048 + head16 * 128; A.sso = sso + q0 * 16 + head16;
    const bool redo = mla ? attn_unit<true, false>(A, lds, wave_in, i & 1) : attn_unit<false, false>(A, lds, wave_in, i & 1);
    if (redo) { if (mla) attn_unit<true, true>(A, lds, wave_in, i & 1); else attn_unit<false, true>(A, lds, wave_in, i & 1); }
  }
}
#undef KSWZ
#undef KSWZ2
#undef SBAR
}

__device__ __forceinline__ void tr_item(const float* W, int ldn, int n0, int k0, const float* gain, bf16* WT, int ldk, int r0, LAS float* scr, int lane) {
#pragma unroll 8
    for (int i = 0; i < 32; ++i) { const int kk = 2 * i + (lane >> 5); float v = 0.f;
        if (n0 >= 0) { v = __builtin_nontemporal_load(W + (size_t)(k0 + kk) * ldn + n0 + (lane & 31)); if (gain) v *= gain[kk]; }
        scr[kk * 33 + (lane & 31)] = v; }
    asm volatile("s_waitcnt lgkmcnt(0)" ::: "memory");
    const int c = lane & 7;
#pragma unroll
    for (int j = 0; j < 4; ++j) { const int n = (lane >> 3) + 8 * j; const LAS float* s = scr + (8 * c) * 33 + n;
        u32x4 o; o.x = pk2(s[0 * 33], s[1 * 33]); o.y = pk2(s[2 * 33], s[3 * 33]); o.z = pk2(s[4 * 33], s[5 * 33]); o.w = pk2(s[6 * 33], s[7 * 33]);
        *(u32x4*)(WT + (size_t)(r0 + n) * ldk + k0 + 8 * c) = o; }
    asm volatile("s_waitcnt lgkmcnt(0)" ::: "memory");
}
__device__ __forceinline__ void tr_item8(const float* W, int ldn, int n0, int k0, float scale, unsigned char* WT, int ldk, int r0, LAS float* scr, int lane) {
#pragma unroll 8
    for (int i = 0; i < 32; ++i) { const int kk = 2 * i + (lane >> 5); scr[kk * 33 + (lane & 31)] = __builtin_nontemporal_load(W + (size_t)(k0 + kk) * ldn + n0 + (lane & 31)) * scale; }
    asm volatile("s_waitcnt lgkmcnt(0)" ::: "memory");
#pragma unroll
    for (int j = 0; j < 2; ++j) { const int q = lane + 64 * j, n = q >> 2, c = q & 3; const LAS float* sp = scr + (16 * c) * 33 + n;
        u32x4 o; o.x = pack4_fp8(sp[0 * 33], sp[1 * 33], sp[2 * 33], sp[3 * 33]); o.y = pack4_fp8(sp[4 * 33], sp[5 * 33], sp[6 * 33], sp[7 * 33]);
        o.z = pack4_fp8(sp[8 * 33], sp[9 * 33], sp[10 * 33], sp[11 * 33]); o.w = pack4_fp8(sp[12 * 33], sp[13 * 33], sp[14 * 33], sp[15 * 33]);
        *(u32x4*)(WT + (size_t)(r0 + n) * ldk + k0 + 16 * c) = o; }
    asm volatile("s_waitcnt lgkmcnt(0)" ::: "memory");
}
constexpr int CI_WIN = (UC / 32) * (DM / 64), CI_WQB = (1536 / 32) * (QL / 64), CI_WKVB = (2048 / 32) * (KVL / 64), CI_WOUT = (2048 / 32) * (2048 / 64),
              CI_G = NE * (EFF / 32) * (DM / 64), CI_D = NE * (DM / 32) * (EFF / 64), CI_LAYER = CI_WIN + CI_WQB + CI_WKVB + CI_WOUT + 2 * CI_G + CI_D;
struct ConvPtrs { const float *w_in, *g_q_lora, *w_q_b, *g_kv_lora, *w_kv_b, *g_out_mla, *g_out_gqa, *w_out, *w_gate, *w_up, *w_down; unsigned char* wt; };
__device__ __forceinline__ void conv_item(int it, const ConvPtrs& P, LAS float* scr, int lane) {
    const int l = it / CI_LAYER; int r = it % CI_LAYER; unsigned char* wl = P.wt + (size_t)l * WL_SIZE;
    if (r < CI_WIN) { const int g = r / (DM / 64), kb = r % (DM / 64); tr_item(P.w_in + (size_t)l * DM * INC, INC, ucol_to_ref(32 * g), 64 * kb, nullptr, (bf16*)(wl + WL_WIN), DM, 32 * g, scr, lane); return; } r -= CI_WIN;
    if (r < CI_WQB) { const int g = r / (QL / 64), kb = r % (QL / 64); int n0;
        if (g < 32) { const int r0 = 32 * g; n0 = (r0 / 128) * QKH + (r0 % 128); } else { const int rr = 32 * (g - 32), t = rr / 256, bj = (rr % 256) / 128, hh = (rr % 128) / 32; n0 = (4 * t + hh) * QKH + NOPE + 32 * bj; }
        tr_item(P.w_q_b + (size_t)l * QL * 1536, 1536, n0, 64 * kb, P.g_q_lora + l * QL + 64 * kb, (bf16*)(wl + WL_WQB), QL, 32 * g, scr, lane); return; } r -= CI_WQB;
    if (r < CI_WKVB) { const int g = r / (KVL / 64), kb = r % (KVL / 64); const int r0 = 32 * g; const int n0 = r0 < 1024 ? (r0 / 128) * 256 + (r0 % 128) : ((r0 - 1024) / 128) * 256 + 128 + ((r0 - 1024) % 128);
        tr_item(P.w_kv_b + (size_t)l * KVL * 2048, 2048, n0, 64 * kb, P.g_kv_lora + l * KVL + 64 * kb, (bf16*)(wl + WL_WKVB), KVL, r0, scr, lane); return; } r -= CI_WKVB;
    if (r < CI_WOUT) { const int g = r / 32, kb = r % 32; const int k0 = 64 * kb; const float* gain = k0 < 1024 ? P.g_out_mla + l * 1024 + k0 : P.g_out_gqa + l * 1024 + (k0 - 1024);
        tr_item(P.w_out + (size_t)l * 2048 * DM, DM, 32 * g, k0, gain, (bf16*)(wl + WL_WOUT), 2048, 32 * g, scr, lane); return; } r -= CI_WOUT;
    if (r < 2 * CI_G) { const int up = r >= CI_G; if (up) r -= CI_G; const int e = r / ((EFF / 32) * (DM / 64)), rr = r % ((EFF / 32) * (DM / 64)), g = rr / (DM / 64), kb = rr % (DM / 64);
        const int c0 = 32 * g; const int r0 = 256 * (c0 / 128) + (c0 % 128) + (up ? 128 : 0);
        if (MOE_F8_GU) tr_item8((up ? P.w_up : P.w_gate) + ((size_t)l * NE + e) * DM * EFF, EFF, c0, 64 * kb, WSCALE8, wl + WL_WGU + (size_t)e * 2048 * 2048, DM, r0, scr, lane);
        else tr_item((up ? P.w_up : P.w_gate) + ((size_t)l * NE + e) * DM * EFF, EFF, c0, 64 * kb, nullptr, (bf16*)(wl + WL_WGU) + (size_t)e * 2048 * 2048, DM, r0, scr, lane);
        return; } r -= 2 * CI_G;
    { const int e = r / ((DM / 32) * (EFF / 64)), rr = r % ((DM / 32) * (EFF / 64)), g = rr / (EFF / 64), kb = rr % (EFF / 64);
      if (MOE_F8_DN) tr_item8(P.w_down + ((size_t)l * NE + e) * EFF * DM, DM, 32 * g, 64 * kb, WDSCALE8, wl + WL_WD + (size_t)e * 2048 * 1024, EFF, 32 * g, scr, lane);
      else tr_item(P.w_down + ((size_t)l * NE + e) * EFF * DM, DM, 32 * g, 64 * kb, nullptr, (bf16*)(wl + WL_WD) + (size_t)e * 2048 * 1024, EFF, 32 * g, scr, lane); }
}

template <int PMODE = 0>
__device__ __forceinline__ void route_rows2(int m, int m_next, u32x2 (&r0)[8], u32x2 (&r1)[8], const bf16* Z, bf16* H1, unsigned char* H1Q, const float* g, const float* b, const LAS float* wr, const float* rbias, int* eidx, float* wts, LAS unsigned* lcnt, LAS unsigned* stash, int lane) {
    f32x4 v0[8], v1[8]; unpack_row(r0, v0); unpack_row(r1, v1);
    ln_apply(v0, g, b, lane); ln_apply(v1, g, b, lane);
    __builtin_amdgcn_sched_barrier(0);
    { const int mn = m_next >= 0 ? m_next : m; load_row_raw(Z + (size_t)mn * DM, r0, lane); load_row_raw(Z + (size_t)(mn + 1) * DM, r1, lane); }
    __builtin_amdgcn_sched_barrier(0);
    if (!(PMODE & 2)) { store_row_bf16(H1 + (size_t)m * DM, v0, lane); store_row_bf16(H1 + (size_t)(m + 1) * DM, v1, lane);
    if (H1Q) { store_row_fp8(H1Q + (size_t)m * DM, v0, lane); store_row_fp8(H1Q + (size_t)(m + 1) * DM, v1, lane); } }
    float a[32];
    f32x4 wA[4], wB[4];
#define RD4(W, E_, H_) { const LAS float* wre = wr + (E_) * 2048 + (H_) * 1024 + 4 * lane; asm volatile("" : "+v"(wre)); _Pragma("unroll") for (int j = 0; j < 4; ++j) W[j] = *(const LAS f32x4*)(wre + 256 * j); }
#define FMAC(ACC, X, W_) asm("v_fmac_f32 %0, %1, %2" : "+v"(ACC) : "v"(X), "v"(W_))
#define FM4(W, H_) { _Pragma("unroll") for (int j = 0; j < 4; ++j) { FMAC(s0, v0[4 * (H_) + j][0], W[j].x); FMAC(t0, v1[4 * (H_) + j][0], W[j].x); FMAC(s1, v0[4 * (H_) + j][1], W[j].y); FMAC(t1, v1[4 * (H_) + j][1], W[j].y); FMAC(s0, v0[4 * (H_) + j][2], W[j].z); FMAC(t0, v1[4 * (H_) + j][2], W[j].z); FMAC(s1, v0[4 * (H_) + j][3], W[j].w); FMAC(t1, v1[4 * (H_) + j][3], W[j].w); } }
    if (PMODE & 1) {
#pragma unroll
        for (int e = 0; e < 16; ++e) { a[e] = v0[e & 7][e >> 3]; a[16 + e] = v1[e & 7][e >> 3]; }
    } else {
        RD4(wA, 0, 0)
#pragma unroll
        for (int e = 0; e < 16; ++e) { float s0 = 0.f, s1 = 0.f, t0 = 0.f, t1 = 0.f;
            RD4(wB, e, 1) __builtin_amdgcn_sched_barrier(0);
            FM4(wA, 0) __builtin_amdgcn_sched_barrier(0);
            if (e + 1 < 16) RD4(wA, e + 1, 0) __builtin_amdgcn_sched_barrier(0);
            FM4(wB, 1) __builtin_amdgcn_sched_barrier(0);
            a[e] = s0 + s1; a[16 + e] = t0 + t1; }
    }
#undef RD4
#undef FM4
#undef FMAC
#define RSTEP(N, MASK) _Pragma("unroll") for (int i = 0; i < (N) / 2; ++i) { const bool up = (lane & (MASK)) != 0; const float send = up ? a[i] : a[(N) / 2 + i]; const float keep = up ? a[(N) / 2 + i] : a[i]; a[i] = keep + __shfl_xor(send, (MASK)); }
    RSTEP(32, 32) RSTEP(16, 16) RSTEP(8, 8) RSTEP(4, 4) RSTEP(2, 2)
#undef RSTEP
    const float tot = a[0] + __shfl_xor(a[0], 1);
    const int e_me = (lane >> 1) & 15, ei = e_me & 3, gi = e_me >> 2;
    const float sc = 1.f / (1.f + __expf(-tot)); const float sel = sc + rbias[e_me];
    const float s1 = __shfl_xor(sel, 2), s2 = __shfl_xor(sel, 4), s3 = __shfl_xor(s1, 4);
    const float hi1 = fmaxf(sel, s1), lo1 = fminf(sel, s1), hi2 = fmaxf(s2, s3), lo2 = fminf(s2, s3);
    const float gsc = fmaxf(hi1, hi2) + fmaxf(fminf(hi1, hi2), fmaxf(lo1, lo2));
    const float g1 = __shfl_xor(gsc, 8), g2 = __shfl_xor(gsc, 16), g3 = __shfl_xor(g1, 16);
    bool win = true;
    win = win && (((gi ^ 1) < gi) ? (gsc > g1) : (gsc >= g1));
    win = win && (((gi ^ 2) < gi) ? (gsc > g2) : (gsc >= g2));
    win = win && (((gi ^ 3) < gi) ? (gsc > g3) : (gsc >= g3));
    int rank = 0;
    rank += (s1 > sel || (s1 == sel && (ei ^ 1) < ei)) ? 1 : 0;
    rank += (s2 > sel || (s2 == sel && (ei ^ 2) < ei)) ? 1 : 0;
    rank += (s3 > sel || (s3 == sel && (ei ^ 3) < ei)) ? 1 : 0;
    const unsigned long long mk1 = __builtin_amdgcn_ballot_w64(win && rank == 0 && !(lane & 1)), mk2 = __builtin_amdgcn_ballot_w64(win && rank == 1 && !(lane & 1));
    const int l1a = __builtin_ctz((unsigned)mk1 | 0x80000000u), l2a = __builtin_ctz((unsigned)mk2 | 0x80000000u);
    const int l1b = 32 + __builtin_ctz((unsigned)(mk1 >> 32) | 0x80000000u), l2b = 32 + __builtin_ctz((unsigned)(mk2 >> 32) | 0x80000000u);
    const int ea = l1a >> 1, eb = l2a >> 1, ec = (l1b >> 1) & 15, ed = (l2b >> 1) & 15;
    const int sci = __builtin_bit_cast(int, sc);
    const float w1a = __builtin_bit_cast(float, __builtin_amdgcn_readlane(sci, l1a)), w2a = __builtin_bit_cast(float, __builtin_amdgcn_readlane(sci, l2a));
    const float w1b = __builtin_bit_cast(float, __builtin_amdgcn_readlane(sci, l1b)), w2b = __builtin_bit_cast(float, __builtin_amdgcn_readlane(sci, l2b));
    if (lane == 0) { const float ia = 1.f / (w1a + w2a), ib = 1.f / (w1b + w2b);
        eidx[2 * m] = ea; eidx[2 * m + 1] = eb; eidx[2 * m + 2] = ec; eidx[2 * m + 3] = ed;
        wts[2 * m] = w1a * ia; wts[2 * m + 1] = w2a * ia; wts[2 * m + 2] = w1b * ib; wts[2 * m + 3] = w2b * ib; }
    if (lane < 4) { const int e = lane == 0 ? ea : lane == 1 ? eb : lane == 2 ? ec : ed;
        const unsigned r = __hip_atomic_fetch_add(lcnt + e, 1u, __ATOMIC_RELAXED, __HIP_MEMORY_SCOPE_WORKGROUP); stash[lane] = ((unsigned)e << 24) | r; }
}

#ifndef FILLER
#define FILLER 1
#endif
constexpr int FILL_D1 = 0, FILL_F1 = 7000, FILL_G1 = 11000;
constexpr int MM = M - 256;
constexpr int XB_Q = 10, XB_KV = 16, XB_LEND = 24;
constexpr int NXA = 10, NXD = 8;
struct Args { const float* in[23]; float* out; unsigned char* ws; int l_lo, l_hi, ph_lo, ph_hi, prologue, use_bar, pad0, pad1; };
__global__ void __launch_bounds__(NWAVES * 64, 2) fwd(Args args) {
    extern __shared__ __attribute__((aligned(16))) unsigned char lds_raw[];
    LAS unsigned char* lds = (LAS unsigned char*)lds_raw;
    volatile LAS unsigned* LC = (volatile LAS unsigned*)(lds + LDSCTL_OFF);
    const int wave = __builtin_amdgcn_readfirstlane(threadIdx.x >> 6);
#define lane lane_id()
#define tid (wave * 64 + lane_id())
    const int G = gridDim.x; const int bx = blockIdx.x; const int vcu = (G % 8 == 0) ? (bx % 8) * (G / 8) + bx / 8 : bx;
    const int gw = vcu * NWAVES + wave, NGW = G * NWAVES;
    unsigned char* ws = (unsigned char*)(GAS unsigned char*)args.ws;
    for (int u = tid; u < (LDS_BYTES - LDSCTL_OFF) / 4; u += NWAVES * 64) LC[u] = 0u;
    __syncthreads();
    XcdBarrier bar; bar.bar = (unsigned*)(ws + WS_CTL) + CW_BAR; bar.x = 0; bar.st = nullptr;
    if (!FLEX || args.use_bar) { bar = xcd_barrier_post((unsigned*)(ws + WS_CTL) + CW_BAR, LC + LC_BAR); if (threadIdx.x == 0) LC[LC_BAR + 2] = bar.x; bar.x = 0; }
#define SEAM() do { if (!FLEX || args.use_bar) { XcdBarrier b2_ = bar; b2_.x = LC[LC_BAR + 2]; GAS unsigned* bp_ = (GAS unsigned*)b2_.bar; asm volatile("" : "+s"(bp_)); b2_.bar = (unsigned*)bp_; xcd_barrier(b2_, wave == 0 && lane_id() == 0); if ((REP_MASK >> 11) & 1) xcd_barrier(b2_, wave == 0 && lane_id() == 0); } } while (0)
#define CAS __attribute__((address_space(4)))
#define GIN(k) ((const float*)(const GAS float*)ap_->in[k])
#define PHASE_PTRS() const CAS Args* ap_ = (const CAS Args*)__builtin_amdgcn_kernarg_segment_ptr(); asm volatile("" : "+s"(ap_));   \
    GAS unsigned char* wsp = (GAS unsigned char*)ap_->ws; int ptid = wave * 64 + lane_id(); asm volatile("" : "+v"(ptid)); const int plane = ptid & 63; (void)plane; \
    int pG = G, pbx = bx, pvcu = vcu, pgw = gw, pNGW = NGW; asm volatile("" : "+s"(pG), "+s"(pbx), "+s"(pvcu), "+s"(pgw), "+s"(pNGW)); (void)pG; (void)pbx; (void)pvcu; (void)pgw; (void)pNGW;   \
    float* cosA = (float*)(wsp + OFF_COSA); float* sinA = (float*)(wsp + OFF_SINA); float* cosB = (float*)(wsp + OFF_COSB); float* sinB = (float*)(wsp + OFF_SINB); \
    bf16* H = (bf16*)(wsp + WS_H); bf16* U = (bf16*)(wsp + WS_U); bf16* QM = (bf16*)(wsp + WS_QM); bf16* KVB = (bf16*)(wsp + WS_KVB); bf16* Y = (bf16*)(wsp + WS_Y); \
    bf16* OA = (bf16*)(wsp + WS_OA); bf16* HE = (bf16*)(wsp + WS_HE); bf16* Z = (bf16*)(wsp + WS_Z); bf16* H1 = (bf16*)(wsp + WS_H1); \
    int* eidx = (int*)(wsp + OFF_EIDX); float* wts = (float*)(wsp + OFF_WTS); int* list = (int*)(wsp + OFF_LIST); \
    float* ssq = (float*)(wsp + OFF_SSQ); float* sskv = (float*)(wsp + OFF_SSKV); float* sso = (float*)(wsp + OFF_SSO); \
    unsigned* cnt = (unsigned*)(wsp + OFF_CNT) + 64 * l; const unsigned char* wl = (const unsigned char*)(wsp + WS_WT + (size_t)l * WL_SIZE); \
    (void)cosA; (void)sinA; (void)cosB; (void)sinB; (void)H; (void)U; (void)QM; (void)KVB; (void)Y; (void)OA; (void)HE; (void)Z; (void)H1; (void)eidx; (void)wts; (void)list; (void)ssq; (void)sskv; (void)sso; (void)cnt; (void)wl

    if (((PH_MASK >> 8) & 1) && (!FLEX || args.prologue)) {
        const int l = 0; PHASE_PTRS();
        const float* x = GIN(0); const float* meta = GIN(1); const float* ln_in_g = GIN(2); const float* ln_in_b = GIN(3);
        ConvPtrs P{GIN(4), GIN(5), GIN(6), GIN(7), GIN(8), GIN(11), GIN(12), GIN(13), GIN(18), GIN(19), GIN(20), (unsigned char*)(wsp + WS_WT)};
        LAS float* scr = (LAS float*)(lds + wave * 16384);
        if (!FLEX || (args.prologue & 1)) for (int rep = 0; rep < NREP(8); ++rep) for (int it = pgw; it < DEPTH * CI_LAYER; it += pNGW) { if (FILLER && it >= CI_LAYER && (it % CI_LAYER) < FILL_G1) continue; conv_item(it, P, scr, plane); }
        if (!FLEX || (args.prologue & 2)) {
            for (int i = (pvcu * NWAVES * 64) + ptid; i < T * 96; i += pG * NWAVES * 64) {
                const int t = i / 96, j = i % 96;
                const float prow = t < NMETA ? -1.f : (float)((t - NMETA) / 64), pcol = t < NMETA ? (float)t : (float)((t - NMETA) % 64);
                float ang;
                if (j < 32) ang = (j < 16 ? prow : pcol) * INV16[j & 15];
                else { const int jj = j - 32; ang = (jj < 32 ? prow : pcol) * INV32[jj & 31]; }
                double s, c; sincos_d((double)ang, s, c);
                if (j < 32) { cosA[t * 32 + j] = (float)c; sinA[t * 32 + j] = (float)s; }
                else { cosB[t * 64 + j - 32] = (float)c; sinB[t * 64 + j - 32] = (float)s; }
            }
            { const float* w_router = GIN(16); float* wrt = (float*)(wsp + OFF_WRT); for (int i = (pvcu * NWAVES * 64) + ptid; i < 16 * 2048; i += pG * NWAVES * 64) { const int e = i >> 11, k = i & 2047; wrt[i] = w_router[k * 16 + e]; } }
            { const int ln = plane; for (int m = pgw; m < M; m += pNGW) ln_in_row(m, x, meta, ln_in_g, ln_in_b, H, ln); }
        }
        SEAM();
    }

#define FILL(nunits, cc, ilo, ihi) do { if (FILLER && l + 1 < DEPTH) { const int rem_ = (nunits) % pG; if ((cc) >= rem_) {     \
        ConvPtrs P{GIN(4), GIN(5), GIN(6), GIN(7), GIN(8), GIN(11), GIN(12), GIN(13), GIN(18), GIN(19), GIN(20), (unsigned char*)(wsp + WS_WT)}; \
        LAS float* scr = (LAS float*)(lds + wave * 16384); const int nw_ = (pG - rem_) * NWAVES; \
        for (int it = (ilo) + ((cc) - rem_) * NWAVES + wave; it < (ihi); it += nw_) conv_item((l + 1) * CI_LAYER + it, P, scr, plane); } } } while (0)
    const int lo = args.ph_lo, hi = args.ph_hi;
#ifndef PH_MASK
#define PH_MASK 0xFFF
#endif
#if FLEX
#define IN(k) (((PH_MASK >> (k)) & 1) && lo <= (k) && (k) < hi)
#else
#define IN(k) ((PH_MASK >> (k)) & 1)
#endif
    for (int l = FLEX ? args.l_lo : 0; l < (FLEX ? args.l_hi : DEPTH); ++l) {
        if (IN(0)) for (int pass = -(int)((REP_MASK >> 0) & 1); pass < 2; ++pass) {
            PHASE_PTRS();
            pg8::DenseSched S; S.init(MM, UC, pG, pbx, DM, DM, (const bf16*)(wl + WL_WIN), (pass == 1 && pbx < NXA) ? pbx : -1, pass <= 0);
            pg8::EpiA E{U, ssq, sskv};
            pg8::gemm_phase<false>(lds, LC + LC_TAB, wave, H, DM, S, E);
            if (pass <= 0) SEAM();
        }
        if (IN(1)) for (int rep = 0; rep < NREP(1); ++rep) {
            PHASE_PTRS(); const float* g_qk_q = GIN(9); const float* g_qk_k = GIN(10);
            const int ln = plane;
            if (pbx < NXA) {
                xsync((unsigned*)(wsp + OFF_CNT) + 64 * (8 + 2 * l), NXA, (unsigned*)(wsp + WS_CTL) + CW_BAR + XB_TMO, ptid == 0);
                for (int m = MM + pbx * NWAVES + wave; m < M; m += NXA * NWAVES) { asm volatile("" ::: "memory"); rowprep_fast(U + (size_t)m * UC, m, (unsigned char*)(wsp + WS_GQ8), (unsigned char*)(wsp + WS_GK8), (unsigned char*)(wsp + WS_KR8), g_qk_q + l * GD, g_qk_k + l * GD, cosA, sinA, cosB, sinB, ln); }
            } else {
                for (int m = (pbx - NXA) * NWAVES + wave; m < MM; m += (pG - NXA) * NWAVES) { asm volatile("" ::: "memory"); rowprep_fast(U + (size_t)m * UC, m, (unsigned char*)(wsp + WS_GQ8), (unsigned char*)(wsp + WS_GK8), (unsigned char*)(wsp + WS_KR8), g_qk_q + l * GD, g_qk_k + l * GD, cosA, sinA, cosB, sinB, ln); }
            }
            { pg8::DenseSched S; S.init(MM, 1536, pG, pbx, UC, QL, (const bf16*)(wl + WL_WQB), -1, 1); pg8::EpiQ E{(unsigned char*)(wsp + WS_QM8), ssq, cosA, sinA}; pg8::gemm_phase<false>(lds, LC + LC_TAB, wave, U + U_CQ, QL, S, E); }
            __syncthreads();
            { pg8::DenseSched S; S.init(MM, 2048, pG, pbx, UC, KVL, (const bf16*)(wl + WL_WKVB), -1, 1); S.lendN = ((MM / 256 * 8) % pG == 0 && pG >= XB_LEND + NXA) ? NXA : 0; S.lendB = XB_LEND;
              pg8::EpiKV E{KVB, (unsigned char*)(wsp + WS_KN8), sskv}; pg8::gemm_phase<false>(lds, LC + LC_TAB, wave, U + U_CKV, KVL, S, E); }
            if (pbx >= XB_Q && pbx < XB_Q + 6) { xwait((unsigned*)(wsp + OFF_CNT) + 64 * (8 + 2 * l), NXA, (unsigned*)(wsp + WS_CTL) + CW_BAR + XB_TMO, ptid == 0);
                pg8::DenseSched S; S.init(MM, 1536, pG, pbx, UC, QL, (const bf16*)(wl + WL_WQB), pbx - XB_Q, 0); pg8::EpiQ E{(unsigned char*)(wsp + WS_QM8), ssq, cosA, sinA}; pg8::gemm_phase<false>(lds, LC + LC_TAB, wave, U + U_CQ, QL, S, E); }
            if (pbx >= XB_KV && pbx < XB_KV + 8) { xwait((unsigned*)(wsp + OFF_CNT) + 64 * (8 + 2 * l), NXA, (unsigned*)(wsp + WS_CTL) + CW_BAR + XB_TMO, ptid == 0);
                pg8::DenseSched S; S.init(MM, 2048, pG, pbx, UC, KVL, (const bf16*)(wl + WL_WKVB), pbx - XB_KV, 0); pg8::EpiKV E{KVB, (unsigned char*)(wsp + WS_KN8), sskv}; pg8::gemm_phase<false>(lds, LC + LC_TAB, wave, U + U_CKV, KVL, S, E); }
            SEAM();
        }
        if (IN(2)) for (int rep = 0; rep < NREP(2); ++rep) {
            PHASE_PTRS();
            att::attn_phase(lds, wave, pG, pvcu, (const unsigned char*)(wsp + WS_QM8), (const unsigned char*)(wsp + WS_GQ8), (const unsigned char*)(wsp + WS_GK8), (const unsigned char*)(wsp + WS_KN8), (const unsigned char*)(wsp + WS_KR8), KVB, U, OA, sso);
            SEAM();
        }
        if (IN(3)) for (int pass = -(int)((REP_MASK >> 3) & 1); pass < 2; ++pass) {
            PHASE_PTRS();
            pg8::DenseSched S; S.init(MM, 2048, pG, pbx, 2048, 2048, (const bf16*)(wl + WL_WOUT), (pass == 1 && pbx < NXD) ? pbx : -1, pass <= 0);
            pg8::EpiD E{Z, H, sso};
            pg8::gemm_phase<false>(lds, LC + LC_TAB, wave, OA, 2048, S, E);
            if (pass <= 0) SEAM();
        }
        if (IN(4)) {
            PHASE_PTRS(); const float* ln1_g = GIN(14); const float* ln1_b = GIN(15); const float* router_bias = GIN(17);
            if (pbx < NXD) xsync((unsigned*)(wsp + OFF_CNT) + 64 * (9 + 2 * l), NXD, (unsigned*)(wsp + WS_CTL) + CW_BAR + XB_TMO, ptid == 0);
            LAS float* wrl = (LAS float*)lds; const int ln = plane;
            { const int td = ptid; const f32x4* wrt = (const f32x4*)(wsp + OFF_WRT); for (int i = td; i < 2048 * 16 / 4; i += NWAVES * 64) ((LAS f32x4*)wrl)[i] = wrt[i]; }
            __syncthreads();
            LAS unsigned* lcnt = (LAS unsigned*)(lds + LDSCTL_OFF) + LC_ECNT; LAS unsigned* lbase = lcnt + 16; LAS unsigned* stash = (LAS unsigned*)(lds + LDSCTL_OFF) + LC_STASH + wave * 128;
            const int m_lo = pbx < NXD ? MM + 2 * (pbx * NWAVES + wave) : 2 * ((pbx - NXD) * NWAVES + wave);
            const int m_hi = pbx < NXD ? M : MM, m_st = pbx < NXD ? 2 * NXD * NWAVES : 2 * (pG - NXD) * NWAVES;
            if ((REP_MASK >> 10) & 1) { int it = 0; LAS unsigned* lcnt2 = (LAS unsigned*)(lds + LDSCTL_OFF) + 2048; LAS unsigned* stash2 = (LAS unsigned*)(lds + LDSCTL_OFF) + 2112 + wave * 128;
              u32x2 r0[8], r1[8]; load_row_raw(Z + (size_t)m_lo * DM, r0, ln); load_row_raw(Z + (size_t)(m_lo + 1) * DM, r1, ln);
#pragma unroll 1
              for (int m = m_lo; m < m_hi; m += m_st, ++it) { asm volatile("" ::: "memory"); route_rows2<PROBE_MODE>(m, m + m_st < m_hi ? m + m_st : -1, r0, r1, Z, H1, MOE_F8_GU ? (unsigned char*)(wsp + WS_H1Q) : (unsigned char*)nullptr, ln1_g + l * DM, ln1_b + l * DM, wrl, router_bias, eidx, wts, lcnt2, stash2 + 4 * it, ln); } }
            { int it = 0;
              u32x2 r0[8], r1[8]; load_row_raw(Z + (size_t)m_lo * DM, r0, ln); load_row_raw(Z + (size_t)(m_lo + 1) * DM, r1, ln);
#pragma unroll 1
              for (int m = m_lo; m < m_hi; m += m_st, ++it) { asm volatile("" ::: "memory"); route_rows2(m, m + m_st < m_hi ? m + m_st : -1, r0, r1, Z, H1, MOE_F8_GU ? (unsigned char*)(wsp + WS_H1Q) : (unsigned char*)nullptr, ln1_g + l * DM, ln1_b + l * DM, wrl, router_bias, eidx, wts, lcnt, stash + 4 * it, ln); } }
            __syncthreads();
            if (ptid < 16) lbase[ptid] = atomicAdd(cnt + ptid, lcnt[ptid]);
            __syncthreads();
            { int it = 0;
#pragma unroll 1
              for (int m = m_lo; m < m_hi; m += m_st, ++it) if (ln < 4) { const unsigned x = stash[4 * it + ln]; const unsigned e = x >> 24, r = x & 0xffffffu; list[(size_t)e * (2 * M) + lbase[e] + r] = 2 * m + ln; } }
            __syncthreads();
            if (ptid < 32) lcnt[ptid] = 0u;
            __syncthreads();
            SEAM();
        }
        if (IN(5) || IN(6)) {
            PHASE_PTRS();
            if (ptid == 0) { int p = 0; for (int e = 0; e < NE; ++e) { const int c = (int)__hip_atomic_load(cnt + e, __ATOMIC_RELAXED, __HIP_MEMORY_SCOPE_AGENT); LC[LC_PRE + e] = (unsigned)p; LC[LC_CNT + e] = (unsigned)c; p += (c + 255) / 256; } LC[LC_PRE + 16] = (unsigned)p; }
            __syncthreads();
        }
        if (IN(5)) for (int rep = 0; rep < NREP(5); ++rep) {
            PHASE_PTRS();
            pg8::MoeSched S{(const volatile LAS int*)(LC + LC_PRE), (const volatile LAS int*)(LC + LC_CNT), list, pG, pvcu, 8, DM, DM, 1, (const void*)(wl + WL_WGU), (size_t)2048 * 2048, MOE_F8_GU ? 1 : 2};
            pg8::EpiGU E{HE, list, MOE_F8_GU ? 1.f / WSCALE8 : 1.f, MOE_F8_DN ? HESCALE8 : 0.f};
            if (MOE_F8_GU) pg8::gemm_phase<true>(lds, LC + LC_TAB, wave, (const void*)(wsp + WS_H1Q), DM, S, E);
            else pg8::gemm_phase<false>(lds, LC + LC_TAB, wave, H1, DM, S, E);
            FILL((int)LC[LC_PRE + 16] * 8, pvcu, FILL_D1, FILL_F1);
            SEAM();
        }
        if (IN(6)) for (int rep = 0; rep < NREP(6); ++rep) {
            PHASE_PTRS();
            pg8::MoeSched S{(const volatile LAS int*)(LC + LC_PRE), (const volatile LAS int*)(LC + LC_CNT), list, pG, pvcu, 8, EFF, EFF, 0, (const void*)(wl + WL_WD), (size_t)2048 * 1024, MOE_F8_DN ? 1 : 2};
            pg8::EpiDown E{Y, list, MOE_F8_DN ? 1.f / (WDSCALE8 * HESCALE8) : 1.f, Y_F8 ? YSCALE8 : 0.f};
            if (MOE_F8_DN) pg8::gemm_phase<true>(lds, LC + LC_TAB, wave, HE, EFF, S, E);
            else pg8::gemm_phase<false>(lds, LC + LC_TAB, wave, HE, EFF, S, E);
            FILL((int)LC[LC_PRE + 16] * 8, pvcu, FILL_F1, FILL_G1);
            SEAM();
        }
        if (IN(7)) for (int rep = 0; rep < NREP(7); ++rep) {
            PHASE_PTRS(); const float* ln2_g = GIN(21); const float* ln2_b = GIN(22);
            const int ln = plane;
#pragma unroll 1
            for (int m = 2 * pgw; m < M; m += 2 * pNGW) { asm volatile("" ::: "memory"); combine_rows2(m, H1, Y, wts, ln2_g + l * DM, ln2_b + l * DM, H, (float*)(GAS float*)ap_->out, l == DEPTH - 1, ln); }
            SEAM();
        }
    }
#undef IN
#undef SEAM
#undef lane
#undef tid
}

static int g_grid = 0;
extern "C" void kernel_launch(void* const* d_in, const int* in_sizes, int n_in, void* d_out, int out_size, void* d_ws, size_t ws_size, hipStream_t stream) {
    if (n_in != 23 || ws_size < WS_END4 || out_size != BATCH * SEQ * DM) { fprintf(stderr, "kernel_launch: unexpected shapes: n_in %d ws %zu (need %zu) out %d\n", n_in, ws_size, (size_t)WS_END4, out_size); return; }
    if (g_grid == 0) {
        int dev = 0, cus = 0;
        if (hipGetDevice(&dev) != hipSuccess || hipDeviceGetAttribute(&cus, hipDeviceAttributeMultiprocessorCount, dev) != hipSuccess) { g_grid = -1; return; }
        if (hipFuncSetAttribute((const void*)fwd, hipFuncAttributeMaxDynamicSharedMemorySize, LDS_BYTES) != hipSuccess) { fprintf(stderr, "hipFuncSetAttribute failed\n"); g_grid = -1; return; }
        g_grid = cus;
    }
    if (g_grid < 0) return;
    unsigned char* ws = (unsigned char*)d_ws;
    (void)hipMemsetAsync(ws + WS_CTL, 0, CTL_ZERO_BYTES, stream);
    Args a{}; for (int i = 0; i < 23; ++i) a.in[i] = (const float*)d_in[i]; a.out = (float*)d_out; a.ws = ws;
    a.l_lo = 0; a.l_hi = DEPTH; a.ph_lo = 0; a.ph_hi = 8; a.prologue = 3; a.use_bar = 1;
    hipLaunchKernelGGL(fwd, dim3(g_grid), dim3(NWAVES * 64), LDS_BYTES, stream, a);
}
```

```cpp
#include <hip/hip_runtime.h>
#include <cstdio>
#include <cstdint>

#ifndef PH_MASK
#define PH_MASK 0xFFF
#endif
#ifndef REP_MASK
#define REP_MASK 0
#endif
#ifndef PROBE_MODE
#define PROBE_MODE 0
#endif
#ifndef SM_TEST
#define SM_TEST 0
#endif
#define NREP(k) (1 + ((REP_MASK >> (k)) & 1))
#ifndef FLEX
#define FLEX 0
#endif
#ifndef Y_F8
#define Y_F8 1
#endif
constexpr float YSCALE8 = 64.f;
typedef unsigned short bf16;
typedef short bf16x8 __attribute__((ext_vector_type(8)));
typedef float f32x4 __attribute__((ext_vector_type(4)));
typedef float f32x16 __attribute__((ext_vector_type(16)));
typedef unsigned u32x4 __attribute__((ext_vector_type(4)));
typedef unsigned u32x2 __attribute__((ext_vector_type(2)));

constexpr int BATCH = 16, SEQ = 2048, DM = 2048, DEPTH = 4, NMETA = 16, T = SEQ + NMETA, M = BATCH * T;
constexpr int QL = 512, KVL = 256, NOPE = 128, ROPE = 64, QKH = 192, NH = 8;
constexpr int GH = 8, GKV = 2, GD = 128;
constexpr int INC = 2368;
constexpr int R_CQ = 0, R_CKV = 512, R_KR = 768, R_GQ = 832, R_GK = 1856, R_GV = 2112;
constexpr int UC = 2560, U_CQ = 0, U_CKV = 512, U_GQ = 768, U_GK = 1792, U_GV = 2048, U_KR = 2304;
constexpr int NE = 16, EFF = 1024;
constexpr float EPS = 1e-6f;
constexpr float ALPHA = 1.681792830507429f;
constexpr float MLA_SCALE = 0.07216878364870322f;
constexpr float GQA_SCALE = 0.08838834764831845f;
constexpr float QSC_M = MLA_SCALE * 1.4426950408889634f * 16.f, QSC_G = GQA_SCALE * 1.4426950408889634f * 16.f;
constexpr int QSCALE_E8 = 0x7b7b7b7b;

__device__ const float INV16[16] = {1.000000000e+00f, 5.623413324e-01f, 3.162277639e-01f, 1.778279394e-01f, 1.000000015e-01f, 5.623413250e-02f, 3.162277490e-02f, 1.778279431e-02f,
                                    9.999999776e-03f, 5.623413250e-03f, 3.162277630e-03f, 1.778279431e-03f, 1.000000047e-03f, 5.623413017e-04f, 3.162277571e-04f, 1.778279402e-04f};
__device__ const float INV32[32] = {1.000000000e+00f, 7.498942614e-01f, 5.623413324e-01f, 4.216965139e-01f, 3.162277639e-01f, 2.371373773e-01f, 1.778279394e-01f, 1.333521307e-01f,
                                    1.000000015e-01f, 7.498941571e-02f, 5.623413250e-02f, 4.216965288e-02f, 3.162277490e-02f, 2.371373773e-02f, 1.778279431e-02f, 1.333521493e-02f,
                                    9.999999776e-03f, 7.498941850e-03f, 5.623413250e-03f, 4.216964822e-03f, 3.162277630e-03f, 2.371373586e-03f, 1.778279431e-03f, 1.333521446e-03f,
                                    1.000000047e-03f, 7.498942432e-04f, 5.623413017e-04f, 4.216965172e-04f, 3.162277571e-04f, 2.371373703e-04f, 1.778279402e-04f, 1.333521504e-04f};

constexpr size_t MiB = 1u << 20;
constexpr size_t SZ_ROW2K = (size_t)M * 2048 * 2;
constexpr size_t WS_CTL = 0;
constexpr size_t CTL_ZERO_BYTES = 256 * 1024;
constexpr size_t OFF_CNT = 128 * 1024;
constexpr size_t WS_TAB = 8 * MiB;
constexpr size_t OFF_COSA = WS_TAB, OFF_SINA = OFF_COSA + (size_t)T * 32 * 4, OFF_COSB = OFF_SINA + (size_t)T * 32 * 4, OFF_SINB = OFF_COSB + (size_t)T * 64 * 4;
constexpr size_t WS_ROUTE = 12 * MiB;
constexpr size_t OFF_EIDX = WS_ROUTE, OFF_WTS = OFF_EIDX + (size_t)M * 8, OFF_LIST = OFF_WTS + (size_t)M * 8;
constexpr size_t OFF_SSQ = 20 * MiB, OFF_SSKV = 21 * MiB + 512 * 1024, OFF_SSO = 22 * MiB;
constexpr size_t OFF_WRT = 25 * MiB;
constexpr size_t WS_H = 32 * MiB;
constexpr size_t WS_U = WS_H + 130 * MiB;
constexpr size_t WS_QM = WS_U + 162 * MiB;
constexpr size_t WS_KVB = WS_QM + 98 * MiB;
constexpr size_t WS_Y = WS_U;
constexpr size_t WS_OA = WS_KVB + 130 * MiB;
constexpr size_t WS_HE = WS_OA;
constexpr size_t WS_Z = WS_OA + 130 * MiB;
constexpr size_t WS_H1 = WS_Z + 130 * MiB;
constexpr size_t WS_END = WS_H1 + 130 * MiB;
static_assert(WS_Y + (size_t)2 * M * 2048 * 2 <= WS_OA, "Y fits in U|QM|KVB");

__device__ __forceinline__ unsigned f2bf(float f) { unsigned u = __float_as_uint(f); return (u + 0x7fffu + ((u >> 16) & 1u)) >> 16; }
__device__ __forceinline__ float bf2f(unsigned b) { return __uint_as_float(b << 16); }
__device__ __forceinline__ unsigned pk2(float lo, float hi) { unsigned r; asm("v_cvt_pk_bf16_f32 %0, %1, %2" : "=v"(r) : "v"(lo), "v"(hi)); return r; }
__device__ __forceinline__ float clamp8(float x) { return __builtin_amdgcn_fmed3f(x, -448.f, 448.f); }
__device__ __forceinline__ unsigned pack4_fp8(float a, float b, float c, float d) { unsigned w = 0u; w = __builtin_amdgcn_cvt_pk_fp8_f32(clamp8(a), clamp8(b), w, false); w = __builtin_amdgcn_cvt_pk_fp8_f32(clamp8(c), clamp8(d), w, true); return w; }
__device__ __forceinline__ float wave_sum(float v) {
#pragma unroll
    for (int o = 1; o < 64; o <<= 1) v += __shfl_xor(v, o);
    return v;
}
__device__ __forceinline__ float wave_max(float v) {
#pragma unroll
    for (int o = 1; o < 64; o <<= 1) v = fmaxf(v, __shfl_xor(v, o));
    return v;
}
__device__ __forceinline__ void ld8(const bf16* p, float (&v)[8]) {
    const u32x4 w = *(const u32x4*)p;
    v[0] = bf2f(w.x & 0xffffu); v[1] = bf2f(w.x >> 16); v[2] = bf2f(w.y & 0xffffu); v[3] = bf2f(w.y >> 16);
    v[4] = bf2f(w.z & 0xffffu); v[5] = bf2f(w.z >> 16); v[6] = bf2f(w.w & 0xffffu); v[7] = bf2f(w.w >> 16);
}
__device__ __forceinline__ void st8(bf16* p, const float (&v)[8]) {
    u32x4 w; w.x = pk2(v[0], v[1]); w.y = pk2(v[2], v[3]); w.z = pk2(v[4], v[5]); w.w = pk2(v[6], v[7]);
    *(u32x4*)p = w;
}
__device__ __forceinline__ int crow(int r, int hi) { return (r & 3) + 8 * (r >> 2) + 4 * hi; }

__device__ __forceinline__ void sincos_d(double x, double& s, double& c) {
    const double k = rint(x * 0.63661977236758134308);
    double r = fma(-k, 1.57079632679489655800, x); r = fma(-k, 6.12323399573676603587e-17, r);
    const int q = ((int)k) & 3; const double r2 = r * r;
    const double sp = r * (1.0 + r2 * (-1.0 / 6 + r2 * (1.0 / 120 + r2 * (-1.0 / 5040 + r2 * (1.0 / 362880 + r2 * (-1.0 / 39916800 + r2 * (1.0 / 6227020800.0 + r2 * (-1.0 / 1307674368000.0))))))));
    const double cp = 1.0 + r2 * (-0.5 + r2 * (1.0 / 24 + r2 * (-1.0 / 720 + r2 * (1.0 / 40320 + r2 * (-1.0 / 3628800 + r2 * (1.0 / 479001600 + r2 * (-1.0 / 87178291200.0 + r2 * (1.0 / 20922789888000.0))))))));
    s = (q == 0) ? sp : (q == 1) ? cp : (q == 2) ? -sp : -cp;
    c = (q == 0) ? cp : (q == 1) ? -sp : (q == 2) ? -cp : sp;
}

__device__ __forceinline__ void ln_apply(f32x4 (&v)[8], const float* g, const float* b, int lane) {
    float s = 0.f;
#pragma unroll
    for (int j = 0; j < 8; ++j) s += (v[j].x + v[j].y) + (v[j].z + v[j].w);
    const float mean = wave_sum(s) * (1.f / DM); float s2 = 0.f;
#pragma unroll
    for (int j = 0; j < 8; ++j) { v[j] = v[j] - mean; s2 += (v[j].x * v[j].x + v[j].y * v[j].y) + (v[j].z * v[j].z + v[j].w * v[j].w); }
    const float rstd = 1.f / sqrtf(wave_sum(s2) * (1.f / DM) + EPS);
#pragma unroll
    for (int j = 0; j < 8; ++j) { const f32x4 gg = *(const f32x4*)(g + 4 * lane + 256 * j), bb = *(const f32x4*)(b + 4 * lane + 256 * j); v[j] = v[j] * rstd * gg + bb; }
}
__device__ __forceinline__ void store_row_bf16(bf16* orow, const f32x4 (&v)[8], int lane) {
#pragma unroll
    for (int j = 0; j < 8; ++j) { u32x2 w; w.x = pk2(v[j].x, v[j].y); w.y = pk2(v[j].z, v[j].w); *(u32x2*)(orow + 4 * lane + 256 * j) = w; }
}
__device__ __forceinline__ void store_row_bf16_nt(bf16* orow, const f32x4 (&v)[8], int lane) {
#pragma unroll
    for (int j = 0; j < 8; ++j) { u32x2 w; w.x = pk2(v[j].x, v[j].y); w.y = pk2(v[j].z, v[j].w); __builtin_nontemporal_store(w, (u32x2*)(orow + 4 * lane + 256 * j)); }
}
__device__ __forceinline__ void store_row_fp8(unsigned char* orow, const f32x4 (&v)[8], int lane) {
#pragma unroll
    for (int j = 0; j < 8; ++j) *(unsigned*)(orow + 4 * lane + 256 * j) = pack4_fp8(v[j].x, v[j].y, v[j].z, v[j].w);
}
__device__ __forceinline__ void load_row_bf16(const bf16* irow, f32x4 (&v)[8], int lane) {
#pragma unroll
    for (int j = 0; j < 8; ++j) { const u32x2 w = *(const u32x2*)(irow + 4 * lane + 256 * j); v[j] = (f32x4){bf2f(w.x & 0xffffu), bf2f(w.x >> 16), bf2f(w.y & 0xffffu), bf2f(w.y >> 16)}; }
}

__device__ __forceinline__ void load_row_raw(const bf16* irow, u32x2 (&r)[8], int lane) {
#pragma unroll
    for (int j = 0; j < 8; ++j) r[j] = __builtin_nontemporal_load((const u32x2*)(irow + 4 * lane + 256 * j));
}
__device__ __forceinline__ void unpack_row(const u32x2 (&r)[8], f32x4 (&v)[8]) {
#pragma unroll
    for (int j = 0; j < 8; ++j) v[j] = (f32x4){bf2f(r[j].x & 0xffffu), bf2f(r[j].x >> 16), bf2f(r[j].y & 0xffffu), bf2f(r[j].y >> 16)};
}

__device__ __forceinline__ void ln_in_row(int m, const float* x, const float* meta, const float* g, const float* b, bf16* H, int lane) {
    const int bb = m / T, t = m % T;
    const float* src = t < NMETA ? meta + (size_t)t * DM : x + ((size_t)bb * SEQ + (t - NMETA)) * DM;
    f32x4 v[8];
#pragma unroll
    for (int j = 0; j < 8; ++j) v[j] = __builtin_nontemporal_load((const f32x4*)(src + 4 * lane + 256 * j));
    ln_apply(v, g, b, lane);
    store_row_bf16(H + (size_t)m * DM, v, lane);
}
__device__ __forceinline__ void unpack8(const u32x4 w, float (&v)[8]) {
    v[0] = bf2f(w.x & 0xffffu); v[1] = bf2f(w.x >> 16); v[2] = bf2f(w.y & 0xffffu); v[3] = bf2f(w.y >> 16); v[4] = bf2f(w.z & 0xffffu); v[5] = bf2f(w.z >> 16); v[6] = bf2f(w.w & 0xffffu); v[7] = bf2f(w.w >> 16);
}
__device__ __forceinline__ void norm_rope_seg(float (&v)[8], const f32x4 g0, const f32x4 g1, const f32x4 c0, const f32x4 c1, const f32x4 s0, const f32x4 s1, bool first, float (&o)[8]) {
    float s = 0.f;
#pragma unroll
    for (int i = 0; i < 8; ++i) s += v[i] * v[i];
    s += __shfl_xor(s, 1); s += __shfl_xor(s, 2); s += __shfl_xor(s, 4); s += __shfl_xor(s, 8);
    const float rs = 1.f / sqrtf(s * (1.f / GD) + EPS);
    const float g[8] = {g0[0], g0[1], g0[2], g0[3], g1[0], g1[1], g1[2], g1[3]}, cs[8] = {c0[0], c0[1], c0[2], c0[3], c1[0], c1[1], c1[2], c1[3]}, sn[8] = {s0[0], s0[1], s0[2], s0[3], s1[0], s1[1], s1[2], s1[3]};
#pragma unroll
    for (int i = 0; i < 8; ++i) { const float y = v[i] * rs * g[i]; const float py = __shfl_xor(y, 8); o[i] = first ? (y * cs[i] - py * sn[i]) : (py * sn[i] + y * cs[i]); }
}
__device__ __forceinline__ void st8_fp8(unsigned char* p, const float (&v)[8]) { u32x2 w; w.x = pack4_fp8(v[0], v[1], v[2], v[3]); w.y = pack4_fp8(v[4], v[5], v[6], v[7]); *(u32x2*)p = w; }
__device__ __forceinline__ void rowprep_fast(const bf16* u, int m, unsigned char* gq8, unsigned char* gk8, unsigned char* kr8, const float* gqq, const float* gqk, const float* cosA, const float* sinA, const float* cosB, const float* sinB, int lane) {
    const int t = m % T;
    const int d0 = (lane & 15) * 8, j0 = d0 & 63; const bool first = (lane & 15) < 8;
    const int ka = (lane & 7) * 8, ja = ka & 31; const bool firsta = (lane & 7) < 4;
    const u32x4 z4 = {0u, 0u, 0u, 0u};
    const u32x4 r0 = __builtin_nontemporal_load((const u32x4*)(u + U_GQ + 8 * lane)), r1 = __builtin_nontemporal_load((const u32x4*)(u + U_GQ + 512 + 8 * lane));
    const u32x4 r2 = lane < 32 ? __builtin_nontemporal_load((const u32x4*)(u + U_GK + 8 * lane)) : z4, r3 = lane < 8 ? __builtin_nontemporal_load((const u32x4*)(u + U_KR + 8 * lane)) : z4;
    const f32x4 gq0 = *(const f32x4*)(gqq + d0), gq1 = *(const f32x4*)(gqq + d0 + 4), gk0 = *(const f32x4*)(gqk + d0), gk1 = *(const f32x4*)(gqk + d0 + 4);
    const f32x4 cb0 = *(const f32x4*)(cosB + t * 64 + j0), cb1 = *(const f32x4*)(cosB + t * 64 + j0 + 4), sb0 = *(const f32x4*)(sinB + t * 64 + j0), sb1 = *(const f32x4*)(sinB + t * 64 + j0 + 4);
    const f32x4 ca0 = *(const f32x4*)(cosA + t * 32 + ja), ca1 = *(const f32x4*)(cosA + t * 32 + ja + 4), sa0 = *(const f32x4*)(sinA + t * 32 + ja), sa1 = *(const f32x4*)(sinA + t * 32 + ja + 4);
    float v[8], o[8];
    { const f32x4 gs0 = gq0 * QSC_G, gs1 = gq1 * QSC_G;
    unpack8(r0, v); norm_rope_seg(v, gs0, gs1, cb0, cb1, sb0, sb1, first, o); st8_fp8(gq8 + (size_t)m * 1024 + 8 * lane, o);
    unpack8(r1, v); norm_rope_seg(v, gs0, gs1, cb0, cb1, sb0, sb1, first, o); st8_fp8(gq8 + (size_t)m * 1024 + 512 + 8 * lane, o); }
    unpack8(r2, v); norm_rope_seg(v, gk0, gk1, cb0, cb1, sb0, sb1, first, o); if (lane < 32) st8_fp8(gk8 + (size_t)m * 256 + 8 * lane, o);
    { unpack8(r3, v); const float cs[8] = {ca0[0], ca0[1], ca0[2], ca0[3], ca1[0], ca1[1], ca1[2], ca1[3]}, sn[8] = {sa0[0], sa0[1], sa0[2], sa0[3], sa1[0], sa1[1], sa1[2], sa1[3]};
#pragma unroll
      for (int i = 0; i < 8; ++i) { const float py = __shfl_xor(v[i], 4); o[i] = firsta ? (v[i] * cs[i] - py * sn[i]) : (py * sn[i] + v[i] * cs[i]); }
      if (lane < 8) st8_fp8(kr8 + (size_t)m * 64 + 8 * lane, o); }
}
__device__ __forceinline__ int ucol_to_ref(int c) {
    if (c < 768) return c;
    if (c < 1792) return R_GQ + (c - 768);
    if (c < 2048) return R_GK + (c - 1792);
    if (c < 2304) return R_GV + (c - 2048);
    if (c < 2368) return R_KR + (c - 2304);
    return -1;
}
__device__ __forceinline__ f32x4 cvt4(const u32x2 w) { return (f32x4){bf2f(w.x & 0xffffu), bf2f(w.x >> 16), bf2f(w.y & 0xffffu), bf2f(w.y >> 16)}; }
__device__ __forceinline__ f32x4 cvt4_fp8(const unsigned w) { const auto lo = __builtin_amdgcn_cvt_pk_f32_fp8((int)w, false), hi = __builtin_amdgcn_cvt_pk_f32_fp8((int)w, true); return (f32x4){lo[0], lo[1], hi[0], hi[1]}; }
__device__ __forceinline__ void combine_rows2(int m, const bf16* H1, const bf16* Y, const float* wts, const float* g, const float* b, bf16* Hn, float* out, bool last, int lane) {
    u32x2 h0[8], h1[8];
    const bf16* hp = H1 + (size_t)m * DM + 4 * lane;
    f32x4 v0[8], v1[8];
    if (Y_F8) {
        unsigned ya[8], yb[8], yc[8], yd[8]; const unsigned char* yp = (const unsigned char*)Y + (size_t)(2 * m) * DM + 4 * lane;
#pragma unroll
        for (int j = 0; j < 8; ++j) { h0[j] = __builtin_nontemporal_load((const u32x2*)(hp + 256 * j)); h1[j] = __builtin_nontemporal_load((const u32x2*)(hp + DM + 256 * j));
            ya[j] = __builtin_nontemporal_load((const unsigned*)(yp + 256 * j)); yb[j] = __builtin_nontemporal_load((const unsigned*)(yp + DM + 256 * j)); yc[j] = __builtin_nontemporal_load((const unsigned*)(yp + 2 * DM + 256 * j)); yd[j] = __builtin_nontemporal_load((const unsigned*)(yp + 3 * DM + 256 * j)); }
        f32x4 w = *(const f32x4*)(wts + 2 * m); w = w * (1.f / YSCALE8);
#pragma unroll
        for (int j = 0; j < 8; ++j) { v0[j] = cvt4(h0[j]) * ALPHA + cvt4_fp8(ya[j]) * w.x + cvt4_fp8(yb[j]) * w.y; v1[j] = cvt4(h1[j]) * ALPHA + cvt4_fp8(yc[j]) * w.z + cvt4_fp8(yd[j]) * w.w; }
    } else {
        u32x2 ya[8], yb[8], yc[8], yd[8]; const bf16* yp = Y + (size_t)(2 * m) * DM + 4 * lane;
#pragma unroll
        for (int j = 0; j < 8; ++j) { h0[j] = *(const u32x2*)(hp + 256 * j); h1[j] = *(const u32x2*)(hp + DM + 256 * j);
            ya[j] = *(const u32x2*)(yp + 256 * j); yb[j] = *(const u32x2*)(yp + DM + 256 * j); yc[j] = *(const u32x2*)(yp + 2 * DM + 256 * j); yd[j] = *(const u32x2*)(yp + 3 * DM + 256 * j); }
        const f32x4 w = *(const f32x4*)(wts + 2 * m);
#pragma unroll
        for (int j = 0; j < 8; ++j) { v0[j] = cvt4(h0[j]) * ALPHA + cvt4(ya[j]) * w.x + cvt4(yb[j]) * w.y; v1[j] = cvt4(h1[j]) * ALPHA + cvt4(yc[j]) * w.z + cvt4(yd[j]) * w.w; }
    }
    ln_apply(v0, g, b, lane); ln_apply(v1, g, b, lane);
    if (!last) { store_row_bf16(Hn + (size_t)m * DM, v0, lane); store_row_bf16(Hn + (size_t)(m + 1) * DM, v1, lane); }
    else {
        { const int bb = m / T, t = m % T; if (t >= NMETA) { float* o = out + ((size_t)bb * SEQ + (t - NMETA)) * DM;
#pragma unroll
            for (int j = 0; j < 8; ++j) __builtin_nontemporal_store(v0[j], (f32x4*)(o + 4 * lane + 256 * j)); } }
        { const int bb = (m + 1) / T, t = (m + 1) % T; if (t >= NMETA) { float* o = out + ((size_t)bb * SEQ + (t - NMETA)) * DM;
#pragma unroll
            for (int j = 0; j < 8; ++j) __builtin_nontemporal_store(v1[j], (f32x4*)(o + 4 * lane + 256 * j)); } }
    }
}
#define LAS __attribute__((address_space(3)))
#define GAS __attribute__((address_space(1)))
constexpr int NWAVES = 8;
constexpr int RING_BYTES = 131072, LDSCTL_OFF = RING_BYTES, LDS_BYTES = 147456;
constexpr int LC_BAR = 0;
constexpr int LC_PRE = 16;
constexpr int LC_CNT = 40;
constexpr int LC_ECNT = 64;
constexpr int LC_STASH = 1024;
constexpr int LC_TAB = 256;
constexpr size_t WL_WIN = 0, WL_WQB = WL_WIN + (size_t)UC * DM * 2, WL_WKVB = WL_WQB + (size_t)1536 * QL * 2, WL_WOUT = WL_WKVB + (size_t)2048 * KVL * 2,
                 WL_WGU = WL_WOUT + (size_t)2048 * 2048 * 2, WL_WD = WL_WGU + (size_t)NE * 2048 * 2048 * 2, WL_SIZE = WL_WD + (size_t)NE * 2048 * 1024 * 2;
constexpr size_t WS_WT = WS_END;
constexpr size_t WS_END2 = WS_WT + 4 * WL_SIZE;
constexpr size_t WS_H1Q = WS_END2;
constexpr size_t WS_END3 = WS_H1Q + 66 * MiB;
constexpr size_t WS_QM8 = WS_END3, WS_GQ8 = WS_QM8 + (size_t)(M + 64) * 1536, WS_GK8 = WS_GQ8 + (size_t)(M + 64) * 1024, WS_KN8 = WS_GK8 + (size_t)(M + 64) * 256, WS_KR8 = WS_KN8 + (size_t)(M + 64) * 1024;
constexpr size_t WS_END4 = ((WS_KR8 + (size_t)(M + 64) * 64 + MiB - 1) / MiB) * MiB;
#ifndef MOE_F8_GU
#define MOE_F8_GU 1
#endif
#ifndef MOE_F8_DN
#define MOE_F8_DN 1
#endif
constexpr float WSCALE8 = 32.f, WDSCALE8 = 64.f, HESCALE8 = 8.f;
constexpr int CW_BAR = 4096;

__device__ __forceinline__ int lane_id() { int r; asm volatile("v_mbcnt_lo_u32_b32 %0, -1, 0\n\tv_mbcnt_hi_u32_b32 %0, -1, %0" : "=v"(r)); return r; }
#define XB_TMO      128
#define XB_XCNT(j)  (256  + 64 * (j))
#define XB_XSUB(j)  (1280 + 64 * (j))
#define XB_XGEN(j)  (2304 + 64 * (j))
#define XB_TOP      3328
#define XB_TOPGEN   3392
#define XCD_BAR_WORDS 3456
#define XB_SPIN_CAP (1u << 20)
__device__ __forceinline__ unsigned xb_ld(unsigned* p)              { return __hip_atomic_load(p, __ATOMIC_RELAXED, __HIP_MEMORY_SCOPE_AGENT); }
__device__ __forceinline__ unsigned xb_add(unsigned* p, unsigned v) { return __hip_atomic_fetch_add(p, v, __ATOMIC_RELAXED, __HIP_MEMORY_SCOPE_AGENT); }
__device__ __forceinline__ unsigned xb_xcc_id() { return (unsigned)__builtin_amdgcn_s_getreg((3 << 11) | 20) & 0xFu; }
#define XB_SPIN(cond, bar) do { unsigned _sp = 0; while (cond) { __builtin_amdgcn_s_sleep(1); \
    if ((++_sp & 255u) == 0u) { if (xb_ld(&(bar)[XB_TMO])) break; if (_sp > XB_SPIN_CAP) { atomicAdd(&(bar)[XB_TMO], 1u); break; } } } } while (0)
struct XcdBarrier { unsigned* bar; unsigned x; volatile LAS unsigned* st; };
__device__ __forceinline__ XcdBarrier xcd_barrier_post(unsigned* bar, volatile LAS unsigned* st) {
    XcdBarrier b; b.bar = bar; b.x = xb_xcc_id(); b.st = st;
    if (__builtin_amdgcn_readfirstlane(threadIdx.x) == 0 && lane_id() == 0) (void)xb_add(&bar[XB_XCNT(b.x)], 1u);
    return b;
}
__device__ __forceinline__ void xcd_barrier_complete(unsigned* bar, unsigned x, unsigned& nloc, unsigned& nx) {
    const unsigned G = gridDim.x * gridDim.y * gridDim.z;
    unsigned sum, cnt, mine, sp = 0u;
    for (;;) {
        sum = 0u; cnt = 0u; mine = 0u;
#pragma unroll
        for (unsigned j = 0; j < 16; ++j) { const unsigned c = xb_ld(&bar[XB_XCNT(j)]); sum += c; cnt += (c > 0u) ? 1u : 0u; mine = (j == x) ? c : mine; }
        if (sum == G) break;
        __builtin_amdgcn_s_sleep(1);
        if ((++sp & 255u) == 0u) { if (xb_ld(&bar[XB_TMO])) break; if (sp > XB_SPIN_CAP) { atomicAdd(&bar[XB_TMO], 1u); break; } }
    }
    nloc = mine > 0u ? mine : 1u; nx = cnt > 0u ? cnt : 1u;
}
__device__ __forceinline__ void xcd_barrier(const XcdBarrier& b, bool leader) {
    asm volatile("s_waitcnt vmcnt(0)" ::: "memory");
    __syncthreads();
    if (leader) {
        unsigned* bar = b.bar;
        __builtin_amdgcn_s_waitcnt(0);
        unsigned nloc = b.st[0], nx = b.st[1];
        if (nloc == 0u) { xcd_barrier_complete(bar, b.x, nloc, nx); b.st[0] = nloc; b.st[1] = nx; }
        const unsigned old = xb_add(&bar[XB_XSUB(b.x)], 1u);
        const unsigned gen = old / nloc;
        if (old + 1u == (gen + 1u) * nloc) {
            __builtin_amdgcn_fence(__ATOMIC_RELEASE, "agent");
            asm volatile("s_waitcnt vmcnt(0)" ::: "memory");
            const unsigned og = xb_add(&bar[XB_TOP], 1u);
            const unsigned tg = og / nx;
            if (og + 1u == (tg + 1u) * nx) xb_add(&bar[XB_TOPGEN], 1u);
            else XB_SPIN(xb_ld(&bar[XB_TOPGEN]) == tg, bar);
            __builtin_amdgcn_fence(__ATOMIC_ACQUIRE, "agent");
            xb_add(&bar[XB_XGEN(b.x)], 1u);
            asm volatile("s_waitcnt vmcnt(0)" ::: "memory");
        } else {
            XB_SPIN(xb_ld(&bar[XB_XGEN(b.x)]) == gen, bar);
            __builtin_amdgcn_fence(__ATOMIC_ACQUIRE, "agent");
            asm volatile("s_waitcnt vmcnt(0)" ::: "memory");
        }
    }
    __syncthreads();
}

__device__ __forceinline__ void xwait(unsigned* cnt, unsigned target, unsigned* tmo, bool leader) {
    __syncthreads();
    if (leader) {
        unsigned sp = 0;
        while (xb_ld(cnt) < target) { __builtin_amdgcn_s_sleep(2); if ((++sp & 255u) == 0u) { if (xb_ld(tmo)) break; if (sp > XB_SPIN_CAP) { atomicAdd(tmo, 1u); break; } } }
        __builtin_amdgcn_fence(__ATOMIC_ACQUIRE, "agent");
        asm volatile("s_waitcnt vmcnt(0)" ::: "memory");
    }
    __syncthreads();
}
__device__ __forceinline__ void xsync(unsigned* cnt, unsigned target, unsigned* tmo, bool leader) {
    asm volatile("s_waitcnt vmcnt(0)" ::: "memory");
    __syncthreads();
    if (leader) {
        __builtin_amdgcn_fence(__ATOMIC_RELEASE, "agent");
        asm volatile("s_waitcnt vmcnt(0)" ::: "memory");
        (void)xb_add(cnt, 1u);
        unsigned sp = 0;
        while (xb_ld(cnt) < target) { __builtin_amdgcn_s_sleep(2); if ((++sp & 255u) == 0u) { if (xb_ld(tmo)) break; if (sp > XB_SPIN_CAP) { atomicAdd(tmo, 1u); break; } } }
        __builtin_amdgcn_fence(__ATOMIC_ACQUIRE, "agent");
        asm volatile("s_waitcnt vmcnt(0)" ::: "memory");
    }
    __syncthreads();
}

namespace pg8 {
typedef float f32x2 __attribute__((ext_vector_type(2)));
constexpr int BM = 256, BK = 64, HALF = 128, HTB = HALF * BK * 2, STAGE_BYTES = 8 * HTB;
__host__ __device__ __forceinline__ int lds_byte(int r, int c) { const int st = (r >> 4) * 2 + (c >> 5), rr = r & 15, cc = c & 31, ob = rr * 64 + cc * 2; return st * 1024 + (ob ^ (((ob >> 9) & 1) << 5)); }
__host__ __device__ __forceinline__ void stage_rc(int b, int& R, int& C) { const int st = b / 1024, sb = b % 1024, swz = sb ^ (((sb >> 9) & 1) << 5); R = (st >> 1) * 16 + swz / 64; C = (st & 1) * 32 + (swz % 64) / 2; }
__host__ __device__ __forceinline__ int perm32(int rho) { const int n = rho >> 4, i = rho & 15; return 8 * (i >> 2) + 4 * n + (i & 3); }
struct Unit { int pm, pn, e, nv; };

__device__ __forceinline__ unsigned cvt_pk_bf16(float lo, float hi) { unsigned r; asm volatile("v_cvt_pk_bf16_f32 %0, %1, %2" : "=v"(r) : "v"(lo), "v"(hi)); return r; }
__device__ __forceinline__ u32x4 pack8(const f32x4& v0, const f32x4& v1) { u32x4 w; w.x = cvt_pk_bf16(v0[0], v0[1]); w.y = cvt_pk_bf16(v0[2], v0[3]); w.z = cvt_pk_bf16(v1[0], v1[1]); w.w = cvt_pk_bf16(v1[2], v1[3]); return w; }

typedef int v8i __attribute__((ext_vector_type(8)));
typedef int v4i __attribute__((ext_vector_type(4)));
__device__ __forceinline__ v8i cat8(const bf16x8 a, const bf16x8 b) { const v4i x = __builtin_bit_cast(v4i, a), y = __builtin_bit_cast(v4i, b); return __builtin_shufflevector(x, y, 0, 1, 2, 3, 4, 5, 6, 7); }
constexpr int FTAB = 2048 - 256;
template <bool F8, class Epi, class Sched>
__device__ __forceinline__ void gemm_phase(LAS unsigned char* lds, volatile LAS unsigned* tab  , int wave_in, const void* A, int K, const Sched& S, const Epi& E) {
    int tid = wave_in * 64 + lane_id(); asm volatile("" : "+v"(tid));
    const int wid = __builtin_amdgcn_readfirstlane(tid >> 6), lane = tid & 63, wr = wid >> 2, wc = wid & 3, fr = lane & 15, fq = lane >> 4;
    constexpr int ESZ = F8 ? 1 : 2;
    const int nt = K * ESZ / 128;
    int sR0, sCB; unsigned voffB[2];
#pragma unroll
    for (int i = 0; i < 2; ++i) { int R, CB;
        if constexpr (F8) { const int sl = tid + i * 512; R = sl >> 3; CB = ((sl & 7) ^ ((R >> 1) & 7)) * 16; }
        else { int C; stage_rc(tid * 16 + i * 8192, R, C); CB = C * 2; }
        if (i == 0) { sR0 = R; sCB = CB; }
        const int Rb = (R & ~31) + perm32(R & 31); voffB[i] = (unsigned)(Rb * K * ESZ + CB); }
    const size_t kstep = (size_t)128;
    const size_t hstep = (size_t)HALF * K * ESZ;
    const int lda = S.lda;
    const size_t hstepA = (size_t)HALF * lda * ESZ;
    const unsigned voffA0 = (unsigned)(sR0 * lda * ESZ + sCB), voffA1 = (unsigned)((sR0 + 64) * lda * ESZ + sCB);
    const unsigned ldsw = (unsigned)wid * 1024u;
    const int aoff = F8 ? (wr * 64 + fr) * 128 + (((2 * fq) ^ ((fr >> 1) & 7)) * 16) : lds_byte(wr * 64 + fr, fq * 8), boff = F8 ? (wc * 32 + fr) * 128 + (((2 * fq) ^ ((fr >> 1) & 7)) * 16) : lds_byte(wc * 32 + fr, fq * 8);
    const int aoffx = aoff ^ 16, boffx = boff ^ 16;
    const char* Ab = (const char*)A;
#define PG8_SA(b, h) (((b) * 2 + (h)) * HTB)
#define PG8_SB(b, h) ((4 + (b) * 2 + (h)) * HTB)
#define PG8_GLDS(gp, lo) __builtin_amdgcn_global_load_lds((const unsigned*)(gp), (LAS unsigned*)(lds + (lo)), 16, 0, 0)
#define PG8_STAGE_B(bufoff, gbase) do { _Pragma("unroll") for (int _i = 0; _i < 2; ++_i) PG8_GLDS((const char*)(gbase) + voffB[_i], (bufoff) + ldsw + _i * 8192); } while (0)
#define PG8_STAGE_A(bufoff, kofs, h, nx) do { \
        if constexpr (Sched::GATHER) { volatile LAS unsigned* _tb = tab + ((((ui) + ((nx) ? 1 : 0)) & 1) << 8) + (h) * HALF + sR0; const unsigned _o0 = _tb[0], _o1 = _tb[64]; \
            PG8_GLDS(Ab + (kofs) + (size_t)(_o0 + (unsigned)sCB), (bufoff) + ldsw); PG8_GLDS(Ab + (kofs) + (size_t)(_o1 + (unsigned)sCB), (bufoff) + ldsw + 8192); } \
        else { const char* _b = ((nx) ? nA : cA) + (kofs) + (size_t)(h) * hstepA; PG8_GLDS(_b + voffA0, (bufoff) + ldsw); PG8_GLDS(_b + voffA1, (bufoff) + ldsw + 8192); } } while (0)
#define PG8_LDA(dst, b, h) do { if constexpr (F8) { _Pragma("unroll") for (int m = 0; m < 4; ++m) dst##8[m] = cat8(*(const LAS bf16x8*)(lds + PG8_SA(b, h) + aoff + m * 2048), *(const LAS bf16x8*)(lds + PG8_SA(b, h) + aoffx + m * 2048)); } \
        else { _Pragma("unroll") for (int m = 0; m < 4; ++m) _Pragma("unroll") for (int k = 0; k < 2; ++k) dst[m][k] = *(const LAS bf16x8*)(lds + PG8_SA(b, h) + aoff + m * 2048 + k * 1024); } } while (0)
#define PG8_LDB(dst, b, h) do { if constexpr (F8) { _Pragma("unroll") for (int n = 0; n < 2; ++n) dst##8[n] = cat8(*(const LAS bf16x8*)(lds + PG8_SB(b, h) + boff + n * 2048), *(const LAS bf16x8*)(lds + PG8_SB(b, h) + boffx + n * 2048)); } \
        else { _Pragma("unroll") for (int n = 0; n < 2; ++n) _Pragma("unroll") for (int k = 0; k < 2; ++k) dst[n][k] = *(const LAS bf16x8*)(lds + PG8_SB(b, h) + boff + n * 2048 + k * 1024); } } while (0)
#define PG8_MMA(ai, bj, At, Bt) do { __builtin_amdgcn_s_setprio(1); \
        if constexpr (F8) { _Pragma("unroll") for (int m = 0; m < 4; ++m) _Pragma("unroll") for (int n = 0; n < 2; ++n) \
            asm volatile("v_mfma_scale_f32_16x16x128_f8f6f4 %0, %1, %2, %0, %3, %3 op_sel_hi:[0,0,0]" : "+v"(acc[ai][bj][m][n]) : "v"(Bt##8[n]), "v"(At##8[m]), "v"(sc8)); }   \
        else { _Pragma("unroll") for (int m = 0; m < 4; ++m) _Pragma("unroll") for (int n = 0; n < 2; ++n) _Pragma("unroll") for (int k = 0; k < 2; ++k) \
            acc[ai][bj][m][n] = __builtin_amdgcn_mfma_f32_16x16x32_bf16(Bt[n][k], At[m][k], acc[ai][bj][m][n], 0, 0, 0); } \
        __builtin_amdgcn_s_setprio(0); } while (0)
#define PG8_WAIT_V(n) asm volatile("s_waitcnt vmcnt(" #n ")" ::: "memory")
#define PG8_WAIT_L(n) asm volatile("s_waitcnt lgkmcnt(" #n ")" ::: "memory")
#define PG8_BAR __builtin_amdgcn_s_barrier()
#define PG8_SCHED __builtin_amdgcn_sched_barrier(0)
    Unit cur, nxt; int ui = 0; int nsl = 0;
    if (!S.next(0, cur)) return;
    if constexpr (Epi::NTAB > 0) {
        Unit uu;
        for (int i = 0; i < 2048 / (256 * Epi::NTAB) && S.next(i, uu); ++i) if (tid < 256) E.fill_tab(tab + FTAB + i * 256 * Epi::NTAB, uu, tid);
        PG8_WAIT_L(0); }
    f32x4 acc[2][2][4][2];
#pragma unroll
    for (int a = 0; a < 2; ++a)
#pragma unroll
        for (int b = 0; b < 2; ++b)
#pragma unroll
            for (int m = 0; m < 4; ++m)
#pragma unroll
                for (int n = 0; n < 2; ++n) acc[a][b][m][n] = (f32x4){0.f, 0.f, 0.f, 0.f};
    const int sc8 = 0x7f7f7f7f;
    bf16x8 At[4][2], B0[2][2], B1[2][2]; v8i At8[4], B08[2], B18[2];
    const char* cA = Ab; const char* nA = Ab;
    if constexpr (Sched::GATHER) { if (tid < 256) { int sid; tab[tid] = S.rowoff(cur, tid, sid); tab[768 + tid] = (unsigned)sid; } PG8_WAIT_L(0); PG8_BAR; }
    else cA = S.aptr(cur, Ab);
    const char* cB = S.bptr(cur);
    const bool nx0 = false;
    PG8_STAGE_B(PG8_SB(0, 0), cB); PG8_STAGE_B(PG8_SB(0, 1), cB + hstep); PG8_STAGE_A(PG8_SA(0, 0), 0, 0, nx0); PG8_STAGE_A(PG8_SA(0, 1), 0, 1, nx0);
    if (wr == 1) PG8_BAR;
    PG8_WAIT_V(2); PG8_BAR;
    PG8_STAGE_B(PG8_SB(1, 0), cB + kstep); PG8_STAGE_A(PG8_SA(1, 0), kstep, 0, nx0); PG8_STAGE_B(PG8_SB(1, 1), cB + hstep + kstep);
    PG8_WAIT_V(6); PG8_BAR;
    for (;;) {
        const bool has_next = S.next(ui + 1, nxt);
        const char* nB = cB; nA = cA;
        if (has_next) { nB = S.bptr(nxt);
            if constexpr (Sched::GATHER) { if (tid < 256) { const int* lp = S.listptr(nxt, tid);
                asm volatile("global_load_dword %0, %1, off" : "=v"(nsl) : "v"(lp) : "memory"); } }
            else nA = S.aptr(nxt, Ab); }
        else { if constexpr (Sched::GATHER) { if (tid < 256) tab[(((ui + 1) & 1) << 8) + tid] = tab[((ui & 1) << 8) + tid]; } }
#pragma unroll 1
        for (int t = 0; t < nt; t += 2) {
            const bool last = (t == nt - 2);
            if constexpr (Sched::GATHER) { if (t == 2 && has_next && tid < 256) {
                asm volatile("s_waitcnt vmcnt(12)" : "+v"(nsl) :: "memory");
                tab[(((ui + 1) & 1) << 8) + tid] = S.off_of(nsl); tab[768 + (((ui + 1) & 1) << 8) + tid] = (unsigned)(tid < nxt.nv ? nsl : -1); } }
            const size_t ka1 = (size_t)(t + 1) * kstep;
            const size_t ka2 = last ? 0 : (size_t)(t + 2) * kstep; const char* b2 = last ? nB : cB + (size_t)(t + 2) * kstep;
            const size_t ka3 = ka2 + kstep; const char* b3 = b2 + kstep;
            if constexpr (Epi::MID) { if (t == nt / 2) {
#pragma unroll
                for (int a = 0; a < 2; ++a)
#pragma unroll
                    for (int m = 0; m < 4; ++m) { const float f = __uint_as_float(tab[FTAB + ui * 512 + a * HALF + wr * 64 + m * 16 + fr]);
#pragma unroll
                        for (int b = 0; b < 2; ++b)
#pragma unroll
                            for (int n = 0; n < 2; ++n) acc[a][b][m][n] = acc[a][b][m][n] * f; } } }
            PG8_LDB(B0, 0, 0); PG8_LDB(B1, 0, 1); PG8_SCHED; PG8_LDA(At, 0, 0); PG8_STAGE_A(PG8_SA(1, 1), ka1, 1, nx0);
            PG8_WAIT_V(8); PG8_WAIT_L(0); PG8_BAR; PG8_MMA(0, 0, At, B0); PG8_MMA(0, 1, At, B1); PG8_BAR; PG8_SCHED;
            PG8_LDA(At, 0, 1); PG8_STAGE_B(PG8_SB(0, 0), b2); PG8_STAGE_B(PG8_SB(0, 1), b2 + hstep); PG8_STAGE_A(PG8_SA(0, 0), ka2, 0, last);
            PG8_WAIT_V(8); PG8_WAIT_L(0); PG8_BAR; PG8_MMA(1, 0, At, B0); PG8_MMA(1, 1, At, B1); PG8_BAR; PG8_SCHED;
            PG8_LDB(B0, 1, 0); PG8_LDB(B1, 1, 1); PG8_SCHED; PG8_LDA(At, 1, 0); PG8_STAGE_A(PG8_SA(0, 1), ka2, 1, last);
            PG8_WAIT_V(8); PG8_WAIT_L(0); PG8_BAR; PG8_MMA(0, 0, At, B0); PG8_MMA(0, 1, At, B1); PG8_BAR; PG8_SCHED;
            PG8_LDA(At, 1, 1); PG8_STAGE_B(PG8_SB(1, 0), b3); PG8_STAGE_B(PG8_SB(1, 1), b3 + hstep); PG8_STAGE_A(PG8_SA(1, 0), ka3, 0, last);
            PG8_WAIT_V(8); PG8_WAIT_L(0); PG8_BAR; PG8_MMA(1, 0, At, B0); PG8_MMA(1, 1, At, B1); PG8_BAR; PG8_SCHED;
        }
        if (wr == 0) PG8_BAR;
        { int fr_e = fr, fq_e = fq; asm volatile("" : "+v"(fr_e), "+v"(fq_e));
          E(acc, cur, wr, wc, fr_e, fq_e, tab, ui); }
        if (!has_next) break;
#pragma unroll
        for (int a = 0; a < 2; ++a)
#pragma unroll
            for (int b = 0; b < 2; ++b)
#pragma unroll
                for (int m = 0; m < 4; ++m)
#pragma unroll
                    for (int n = 0; n < 2; ++n) acc[a][b][m][n] = (f32x4){0.f, 0.f, 0.f, 0.f};
        cur = nxt; cB = nB; cA = nA; ++ui;
        if (wr == 1) PG8_BAR;
    }
    PG8_WAIT_V(0);
    PG8_BAR;
#undef PG8_SA
#undef PG8_SB
#undef PG8_GLDS
#undef PG8_STAGE_A
#undef PG8_STAGE_B
#undef PG8_LDA
#undef PG8_LDB
#undef PG8_MMA
#undef PG8_WAIT_V
#undef PG8_WAIT_L
#undef PG8_BAR
#undef PG8_SCHED
}

struct DenseSched {
    static constexpr bool GATHER = false;
    int nM, nN, nwg, G, c, lda, K, xpn, has_main, lendN = 0, lendB = 0; const bf16* Bt; static constexpr int esz = 2;
    __device__ __forceinline__ void init(int M_, int N_, int G_, int c_, int lda_, int K_, const bf16* Bt_, int xpn_ = -1, int has_main_ = 1) { nM = M_ / BM; nN = N_ / BM; nwg = nM * nN; G = G_; c = c_; lda = lda_; K = K_; Bt = Bt_; xpn = xpn_; has_main = has_main_; }
    __device__ __forceinline__ bool next(int i_in, Unit& u) const { int i = i_in;
        if (xpn >= 0) { if (i == 0) { u.pm = nM; u.pn = xpn; u.e = 0; u.nv = 256; return true; } --i; }
        if (!has_main) return false;
        int cc = c;
        if (lendN > 0) { const int nmain = nwg / G; if (c < lendN && i >= nmain - 1) return false; if (i == nmain) { if (c < lendB || c >= lendB + lendN) return false; cc = c - lendB; i = nmain - 1; } }
        const long L = (long)i * G + cc; if (L >= nwg) return false;
        int wgid = (int)L; { const int q = nwg / 8, r = nwg % 8, xcd = wgid % 8, off = wgid / 8; wgid = (xcd < r ? xcd * (q + 1) : r * (q + 1) + (xcd - r) * q) + off; }
        const int nig = 8 * nN, gid = wgid / nig, fm = gid * 8, gsz = (nM - fm) < 8 ? (nM - fm) : 8;
        u.pm = fm + ((wgid % nig) % gsz); u.pn = (wgid % nig) / gsz; u.e = 0; u.nv = 256; return true;
    }
    __device__ __forceinline__ const char* bptr(const Unit& u) const { return (const char*)Bt + (size_t)u.pn * BM * K * 2; }
    __device__ __forceinline__ const char* aptr(const Unit& u, const char* Ab) const { return Ab + (size_t)u.pm * BM * lda * 2; }
    __device__ __forceinline__ unsigned rowoff(const Unit&, int) const { return 0u; }
};
struct MoeSched {
    static constexpr bool GATHER = true;
    const volatile LAS int* pre; const volatile LAS int* cn; const int* list; int G, c, npn, lda, K, tok; const void* Bt; size_t estride; int esz;
    __device__ __forceinline__ bool next(int i, Unit& u) const {
        const int L = i * G + c; const int tt = L / npn; if (tt >= __builtin_amdgcn_readfirstlane(pre[16])) return false;
        int e = 0;
#pragma unroll
        for (int k = 1; k < 16; ++k) e += (tt >= pre[k]) ? 1 : 0;
        u.e = __builtin_amdgcn_readfirstlane(e); u.pm = __builtin_amdgcn_readfirstlane(tt - pre[e]); u.pn = L % npn; u.nv = __builtin_amdgcn_readfirstlane(cn[e] - (tt - pre[e]) * BM); return true;
    }
    __device__ __forceinline__ const char* bptr(const Unit& u) const { return (const char*)Bt + ((size_t)u.e * estride + (size_t)u.pn * BM * K) * esz; }
    __device__ __forceinline__ const char* aptr(const Unit&, const char* Ab) const { return Ab; }
    __device__ __forceinline__ const int* listptr(const Unit& u, int r) const { const int idx = r < u.nv ? u.pm * BM + r : u.pm * BM; return list + (size_t)u.e * (2 * M) + idx; }
    __device__ __forceinline__ unsigned off_of(int slot) const { return (unsigned)(tok ? (slot >> 1) : slot) * (unsigned)(lda * esz); }
    __device__ __forceinline__ unsigned rowoff(const Unit& u, int r, int& sid) const {
        const int idx = r < u.nv ? u.pm * BM + r : u.pm * BM;
        const int slot = list[(size_t)u.e * (2 * M) + idx];
        sid = r < u.nv ? slot : -1;
        return (unsigned)(tok ? (slot >> 1) : slot) * (unsigned)(lda * esz);
    }
};

struct EpiA {
    static constexpr bool MID = false; static constexpr int NTAB = 0;
    bf16* U; float* ssq; float* sskv;
    __device__ __forceinline__ void operator()(const f32x4 (&acc)[2][2][4][2], const Unit& u, int wr, int wc, int fr, int fq, const volatile LAS unsigned* tab, int ui) const {
        const int row0 = u.pm * BM + wr * 64 + fr, col0 = u.pn * BM + wc * 32 + 8 * fq;
#pragma unroll
        for (int ai = 0; ai < 2; ++ai)
#pragma unroll
            for (int m = 0; m < 4; ++m) { bf16* rowp = U + (size_t)(row0 + ai * HALF + m * 16) * UC + col0;
#pragma unroll
                for (int bj = 0; bj < 2; ++bj) *(u32x4*)(rowp + bj * HALF) = pack8(acc[ai][bj][m][0], acc[ai][bj][m][1]); }
        if (u.pn <= 2) {
#pragma unroll
            for (int ai = 0; ai < 2; ++ai)
#pragma unroll
                for (int m = 0; m < 4; ++m) { float s = 0.f;
#pragma unroll
                    for (int bj = 0; bj < 2; ++bj)
#pragma unroll
                        for (int n = 0; n < 2; ++n) { const f32x4 x = acc[ai][bj][m][n]; s += (x[0] * x[0] + x[1] * x[1]) + (x[2] * x[2] + x[3] * x[3]); }
                    s += __shfl_xor(s, 16); s += __shfl_xor(s, 32);
                    const int row = row0 + ai * HALF + m * 16;
                    if (fq == 0) { if (u.pn < 2) ssq[row * 8 + u.pn * 4 + wc] = s; else sskv[row * 4 + wc] = s; } } }
    }
};
struct EpiQ {
    static constexpr bool MID = false; static constexpr int NTAB = 1;
    __device__ __forceinline__ void fill_tab(volatile LAS unsigned* t, const Unit& u, int r) const { const int row = u.pm * BM + r; const f32x4 q0 = *(const f32x4*)(ssq + row * 8), q1 = *(const f32x4*)(ssq + row * 8 + 4);
        t[r] = __float_as_uint(rsqrtf(((((q0[0] + q0[1]) + (q0[2] + q0[3])) + ((q1[0] + q1[1]) + (q1[2] + q1[3])))) * (1.f / QL) + EPS)); }
    unsigned char* QM; const float* ssq; const float* cosA; const float* sinA;
    static __device__ __forceinline__ u32x2 pk8(const f32x4 a, const f32x4 b) { u32x2 w; w.x = pack4_fp8(a[0], a[1], a[2], a[3]); w.y = pack4_fp8(b[0], b[1], b[2], b[3]); return w; }
    __device__ __forceinline__ void operator()(const f32x4 (&acc)[2][2][4][2], const Unit& u, int wr, int wc, int fr, int fq, const volatile LAS unsigned* tab, int ui) const {
        const int row0 = u.pm * BM + wr * 64 + fr;
        float rs[2][4];
#pragma unroll
        for (int ai = 0; ai < 2; ++ai)
#pragma unroll
            for (int m = 0; m < 4; ++m) rs[ai][m] = __uint_as_float(tab[FTAB + ui * 256 + ai * HALF + wr * 64 + m * 16 + fr]) * QSC_M;
#define EPIQ_ST16(PTR, AX, AY, BX, BY) { auto r0_ = __builtin_amdgcn_permlane16_swap(AX, BX, false, false); auto r1_ = __builtin_amdgcn_permlane16_swap(AY, BY, false, false); \
            u32x4 w_; w_.x = r0_[0]; w_.y = r1_[0]; w_.z = r0_[1]; w_.w = r1_[1]; *(u32x4*)(PTR) = w_; }
        const int fqe = 8 * (fq & ~1);
        if (u.pn < 4) {
#pragma unroll
            for (int ai = 0; ai < 2; ++ai)
#pragma unroll
                for (int mp = 0; mp < 4; mp += 2) { unsigned char* rowp = QM + (size_t)(row0 + ai * HALF + (mp + (fq & 1)) * 16) * 1536; const float ra = rs[ai][mp], rb = rs[ai][mp + 1];
#pragma unroll
                    for (int bj = 0; bj < 2; ++bj) { const u32x2 wa = pk8(acc[ai][bj][mp][0] * ra, acc[ai][bj][mp][1] * ra), wb = pk8(acc[ai][bj][mp + 1][0] * rb, acc[ai][bj][mp + 1][1] * rb);
                        EPIQ_ST16(rowp + (2 * u.pn + bj) * QKH + wc * 32 + fqe, wa.x, wa.y, wb.x, wb.y) } }
        } else {
            const int head = 4 * (u.pn - 4) + wc;
#pragma unroll
            for (int g2 = 0; g2 < 4; ++g2) { const int ai = g2 >> 1, mb = (g2 & 1) * 2;
                f32x4 cs[2][4];
#pragma unroll
                for (int mm = 0; mm < 2; ++mm) { const int t = (row0 + ai * HALF + (mb + mm) * 16) % T;
                    cs[mm][0] = *(const f32x4*)(cosA + t * 32 + 8 * fq); cs[mm][1] = *(const f32x4*)(cosA + t * 32 + 8 * fq + 4); cs[mm][2] = *(const f32x4*)(sinA + t * 32 + 8 * fq); cs[mm][3] = *(const f32x4*)(sinA + t * 32 + 8 * fq + 4); }
                u32x2 lo[2], hi2[2];
#pragma unroll
                for (int mm = 0; mm < 2; ++mm) { const int m = mb + mm; const float r = rs[ai][m];
                    const f32x4 a0 = acc[ai][0][m][0] * r, a1 = acc[ai][0][m][1] * r, b0 = acc[ai][1][m][0] * r, b1 = acc[ai][1][m][1] * r;
                    lo[mm] = pk8(a0 * cs[mm][0] - b0 * cs[mm][2], a1 * cs[mm][1] - b1 * cs[mm][3]);
                    hi2[mm] = pk8(a0 * cs[mm][2] + b0 * cs[mm][0], a1 * cs[mm][3] + b1 * cs[mm][1]); }
                unsigned char* rowp = QM + (size_t)(row0 + ai * HALF + (mb + (fq & 1)) * 16) * 1536 + head * QKH + NOPE + fqe;
                EPIQ_ST16(rowp, lo[0].x, lo[0].y, lo[1].x, lo[1].y)
                EPIQ_ST16(rowp + 32, hi2[0].x, hi2[0].y, hi2[1].x, hi2[1].y)
                asm volatile("" ::: "memory"); }
        }
#undef EPIQ_ST16
    }
};
struct EpiKV {
    static constexpr bool MID = false; static constexpr int NTAB = 1;
    __device__ __forceinline__ void fill_tab(volatile LAS unsigned* t, const Unit& u, int r) const { const f32x4 q0 = *(const f32x4*)(sskv + (u.pm * BM + r) * 4); t[r] = __float_as_uint(rsqrtf(((q0[0] + q0[1]) + (q0[2] + q0[3])) * (1.f / KVL) + EPS)); }
    bf16* KVB; unsigned char* KN8; const float* sskv;
    __device__ __forceinline__ void operator()(const f32x4 (&acc)[2][2][4][2], const Unit& u, int wr, int wc, int fr, int fq, const volatile LAS unsigned* tab, int ui) const {
        const int row0 = u.pm * BM + wr * 64 + fr, col0 = u.pn * BM + wc * 32 + 8 * fq;
        float rs[2][4];
#pragma unroll
        for (int ai = 0; ai < 2; ++ai)
#pragma unroll
            for (int m = 0; m < 4; ++m) rs[ai][m] = __uint_as_float(tab[FTAB + ui * 256 + ai * HALF + wr * 64 + m * 16 + fr]);
        if (u.pn < 4) {
            const int colp = u.pn * BM + wc * 32 + 8 * (fq & ~1);
#pragma unroll
            for (int ai = 0; ai < 2; ++ai)
#pragma unroll
                for (int mp = 0; mp < 4; mp += 2) { const size_t row = (size_t)(row0 + ai * HALF + (mp + (fq & 1)) * 16); const float ra = rs[ai][mp], rb = rs[ai][mp + 1];
#pragma unroll
                    for (int bj = 0; bj < 2; ++bj) { const f32x4 a0 = acc[ai][bj][mp][0] * ra, a1 = acc[ai][bj][mp][1] * ra, b0 = acc[ai][bj][mp + 1][0] * rb, b1 = acc[ai][bj][mp + 1][1] * rb;
                        const unsigned ax = pack4_fp8(a0[0], a0[1], a0[2], a0[3]), ay = pack4_fp8(a1[0], a1[1], a1[2], a1[3]), bx = pack4_fp8(b0[0], b0[1], b0[2], b0[3]), by = pack4_fp8(b1[0], b1[1], b1[2], b1[3]);
                        auto r0 = __builtin_amdgcn_permlane16_swap(ax, bx, false, false); auto r1 = __builtin_amdgcn_permlane16_swap(ay, by, false, false);
                        u32x4 w; w.x = r0[0]; w.y = r1[0]; w.z = r0[1]; w.w = r1[1];
                        *(u32x4*)(KN8 + row * 1024 + colp + bj * HALF) = w; } }
        } else {
#pragma unroll
            for (int ai = 0; ai < 2; ++ai)
#pragma unroll
                for (int m = 0; m < 4; ++m) { const size_t row = (size_t)(row0 + ai * HALF + m * 16); const float r = rs[ai][m];
#pragma unroll
                    for (int bj = 0; bj < 2; ++bj) *(u32x4*)(KVB + row * 2048 + col0 + bj * HALF) = pack8(acc[ai][bj][m][0] * r, acc[ai][bj][m][1] * r); }
        }
    }
};
struct EpiD {
    static constexpr bool MID = true; static constexpr int NTAB = 2;
    bf16* Z; const bf16* H; const float* sso;
    __device__ __forceinline__ float sum8(const float* p) const { const f32x4 a = *(const f32x4*)p, b = *(const f32x4*)(p + 4); return ((a[0] + a[1]) + (a[2] + a[3])) + ((b[0] + b[1]) + (b[2] + b[3])); }
    __device__ __forceinline__ void fill_tab(volatile LAS unsigned* t, const Unit& u, int r) const { const int row = u.pm * BM + r;
        const float va = sum8(sso + (size_t)row * 16) * (1.f / 1024) + EPS, vb = sum8(sso + (size_t)row * 16 + 8) * (1.f / 1024) + EPS;
        t[r] = __float_as_uint(rsqrtf(va) * sqrtf(vb)); t[256 + r] = __float_as_uint(rsqrtf(vb)); }
    __device__ __forceinline__ void operator()(const f32x4 (&acc)[2][2][4][2], const Unit& u, int wr, int wc, int fr, int fq, const volatile LAS unsigned* tab, int ui) const {
        const int row0 = u.pm * BM + wr * 64 + fr, col0 = u.pn * BM + wc * 32 + 8 * fq;
        float rs[2][4];
#pragma unroll
        for (int ai = 0; ai < 2; ++ai)
#pragma unroll
            for (int m = 0; m < 4; ++m) rs[ai][m] = __uint_as_float(tab[FTAB + ui * 512 + 256 + ai * HALF + wr * 64 + m * 16 + fr]);
        u32x4 hv[2][2][2];
#define EPID_LOAD(G2, BUF) { const int ai_ = (G2) >> 1, mb_ = ((G2) & 1) * 2; _Pragma("unroll") for (int mm = 0; mm < 2; ++mm) _Pragma("unroll") for (int bj = 0; bj < 2; ++bj) \
            hv[BUF][mm][bj] = __builtin_nontemporal_load((const u32x4*)(H + (size_t)(row0 + ai_ * HALF + (mb_ + mm) * 16) * 2048 + col0 + bj * HALF)); }
        EPID_LOAD(0, 0)
#pragma unroll
        for (int g2 = 0; g2 < 4; ++g2) { const int ai = g2 >> 1, mb = (g2 & 1) * 2;
            if (g2 + 1 < 4) { if (g2 & 1) EPID_LOAD(g2 + 1, 0) else EPID_LOAD(g2 + 1, 1) }
            __builtin_amdgcn_sched_barrier(0);
#pragma unroll
            for (int mm = 0; mm < 2; ++mm) { const int m = mb + mm; const size_t off = (size_t)(row0 + ai * HALF + m * 16) * 2048 + col0; const float r = rs[ai][m];
#pragma unroll
                for (int bj = 0; bj < 2; ++bj) { const u32x4 h = hv[g2 & 1][mm][bj];
                    const f32x4 h0 = {bf2f(h.x & 0xffffu), bf2f(h.x >> 16), bf2f(h.y & 0xffffu), bf2f(h.y >> 16)}, h1 = {bf2f(h.z & 0xffffu), bf2f(h.z >> 16), bf2f(h.w & 0xffffu), bf2f(h.w >> 16)};
                    *(u32x4*)(Z + off + bj * HALF) = pack8(h0 * ALPHA + acc[ai][bj][m][0] * r, h1 * ALPHA + acc[ai][bj][m][1] * r); } }
            __builtin_amdgcn_sched_barrier(0); }
#undef EPID_LOAD
    }
};
struct EpiGU {
    static constexpr bool MID = false; static constexpr int NTAB = 0;
    bf16* HE; const int* list; float inscale; float oscale8;
    __device__ __forceinline__ void operator()(const f32x4 (&acc)[2][2][4][2], const Unit& u, int wr, int wc, int fr, int fq, const volatile LAS unsigned* tab, int ui) const {
        for (int prep = 0; prep < 1 + ((PROBE_MODE >> 3) & 1); ++prep) { asm volatile("" ::: "memory");
        if (oscale8 > 0.f) {
            const int colp = u.pn * HALF + wc * 32 + 8 * (fq & ~1);
#pragma unroll
            for (int ai = 0; ai < 2; ++ai)
#pragma unroll
                for (int mp = 0; mp < 4; mp += 2) { const int sl = (int)tab[768 + ((ui & 1) << 8) + ai * HALF + wr * 64 + (mp + (fq & 1)) * 16 + fr];
                    unsigned pk[2][2];
#pragma unroll
                    for (int mm = 0; mm < 2; ++mm)
#pragma unroll
                        for (int n = 0; n < 2; ++n) { float o[4];
#pragma unroll
                            for (int i = 0; i < 4; ++i) { const float g = acc[ai][0][mp + mm][n][i] * inscale, uu = acc[ai][1][mp + mm][n][i] * inscale; o[i] = g * __builtin_amdgcn_rcpf(1.f + __expf(-g)) * uu * oscale8; }
                            pk[mm][n] = pack4_fp8(o[0], o[1], o[2], o[3]); }
                    auto r0 = __builtin_amdgcn_permlane16_swap(pk[0][0], pk[1][0], false, false); auto r1 = __builtin_amdgcn_permlane16_swap(pk[0][1], pk[1][1], false, false);
                    u32x4 w; w.x = r0[0]; w.y = r1[0]; w.z = r0[1]; w.w = r1[1];
                    if (sl >= 0) *(u32x4*)((unsigned char*)HE + (size_t)sl * EFF + colp) = w;
                    __builtin_amdgcn_sched_barrier(0); }
        } else {
#pragma unroll
        for (int ai = 0; ai < 2; ++ai)
#pragma unroll
            for (int m = 0; m < 4; ++m) { const int sl = (int)tab[768 + ((ui & 1) << 8) + ai * HALF + wr * 64 + m * 16 + fr]; if (sl >= 0) { f32x4 o[2];
#pragma unroll
                for (int n = 0; n < 2; ++n)
#pragma unroll
                    for (int i = 0; i < 4; ++i) { const float g = acc[ai][0][m][n][i] * inscale, uu = acc[ai][1][m][n][i] * inscale; o[n][i] = g * __builtin_amdgcn_rcpf(1.f + __expf(-g)) * uu; }
                *(u32x4*)(HE + (size_t)sl * EFF + u.pn * HALF + wc * 32 + 8 * fq) = pack8(o[0], o[1]); } }
        }
        }
    }
};
struct EpiDown {
    static constexpr bool MID = false; static constexpr int NTAB = 0;
    bf16* Y; const int* list; float inscale; float oscale8;
    __device__ __forceinline__ void operator()(const f32x4 (&acc)[2][2][4][2], const Unit& u, int wr, int wc, int fr, int fq, const volatile LAS unsigned* tab, int ui) const {
        const int col0 = u.pn * BM + wc * 32 + 8 * fq;
        for (int prep = 0; prep < 1 + ((PROBE_MODE >> 2) & 1); ++prep) { asm volatile("" ::: "memory");
        if (oscale8 > 0.f) {
            const float sc = inscale * oscale8; const int colp = u.pn * BM + wc * 32 + 8 * (fq & ~1);
#pragma unroll
            for (int ai = 0; ai < 2; ++ai)
#pragma unroll
                for (int mp = 0; mp < 4; mp += 2) { const int sl = (int)tab[768 + ((ui & 1) << 8) + ai * HALF + wr * 64 + (mp + (fq & 1)) * 16 + fr];
#pragma unroll
                    for (int bj = 0; bj < 2; ++bj) {
                        const f32x4 a0 = acc[ai][bj][mp][0] * sc, a1 = acc[ai][bj][mp][1] * sc, b0 = acc[ai][bj][mp + 1][0] * sc, b1 = acc[ai][bj][mp + 1][1] * sc;
                        const unsigned ax = pack4_fp8(a0[0], a0[1], a0[2], a0[3]), ay = pack4_fp8(a1[0], a1[1], a1[2], a1[3]), bx = pack4_fp8(b0[0], b0[1], b0[2], b0[3]), by = pack4_fp8(b1[0], b1[1], b1[2], b1[3]);
                        auto r0 = __builtin_amdgcn_permlane16_swap(ax, bx, false, false); auto r1 = __builtin_amdgcn_permlane16_swap(ay, by, false, false);
                        u32x4 w; w.x = r0[0]; w.y = r1[0]; w.z = r0[1]; w.w = r1[1];
                        if (sl >= 0) *(u32x4*)((unsigned char*)Y + (size_t)sl * DM + colp + bj * HALF) = w; }
                    __builtin_amdgcn_sched_barrier(0); }
        } else {
#pragma unroll
        for (int ai = 0; ai < 2; ++ai)
#pragma unroll
            for (int m = 0; m < 4; ++m) { const int sl = (int)tab[768 + ((ui & 1) << 8) + ai * HALF + wr * 64 + m * 16 + fr]; if (sl >= 0) { bf16* rowp = Y + (size_t)sl * DM + col0;
#pragma unroll
                    for (int bj = 0; bj < 2; ++bj) *(u32x4*)(rowp + bj * HALF) = pack8(acc[ai][bj][m][0] * inscale, acc[ai][bj][m][1] * inscale); } }
        }
        }
    }
};
}


namespace att {
using s16x4 = __attribute__((ext_vector_type(4))) short;
constexpr int NW = 8, QBLK = 32, KVBLK = 64, NT = (T + KVBLK - 1) / KVBLK;
static_assert(NT % 2 == 1 && T - (NT - 1) * KVBLK == 16, "tail handling below is written for an odd tile count with a 16-key last tile");
constexpr int SHM_V = 16384, SHM_K = 8192, SHM_K2 = 4096;
constexpr int OFF_V = 0, OFF_K = 2 * SHM_V, OFF_K2 = OFF_K + 2 * SHM_K, OFF_WS = OFF_K2 + 2 * SHM_K2, ATT_LDS = OFF_WS + NW * 256;
constexpr int OST_PITCH = 272, OST_WAVE = 32 * OST_PITCH, OFF_OST = 61440;
static_assert(ATT_LDS <= OFF_OST && OFF_OST + 8 * OST_WAVE <= RING_BYTES, "attention LDS map");
static_assert(ATT_LDS <= RING_BYTES, "attention LDS");
#define KSWZ(row, colB) ((row) * 256 + ((colB) ^ (((row) & 7) << 4)))
#define KSWZ2(row, colB) ((row) * 128 + ((colB) ^ ((((row) >> 1) & 7) << 4)))
#define SBAR() __builtin_amdgcn_sched_barrier(0)
__device__ __forceinline__ unsigned cvtpk(float lo, float hi) { unsigned r; asm volatile("v_cvt_pk_bf16_f32 %0, %1, %2" : "=v"(r) : "v"(lo), "v"(hi)); return r; }
__device__ __forceinline__ void partialSM(f32x16& p0, f32x16& p1, float& m_reg, float& mn, float& alpha, float C, float thr) {
  float pmax = p0[0];
#pragma unroll
  for (int r = 1; r < 16; ++r) pmax = fmaxf(pmax, p0[r]);
#pragma unroll
  for (int r = 0; r < 16; ++r) pmax = fmaxf(pmax, p1[r]);
  { auto rr = __builtin_amdgcn_permlane32_swap(__float_as_uint(pmax), __float_as_uint(pmax), false, false);
    pmax = fmaxf(__uint_as_float(rr[0]), __uint_as_float(rr[1])); }
  if (__builtin_expect(__all(pmax - m_reg <= thr), 1)) { mn = m_reg; alpha = 1.f; }
  else { mn = fmaxf(m_reg, pmax); alpha = __builtin_amdgcn_exp2f((m_reg - mn) * C); m_reg = mn; }
  const float mnC = -mn * C;
#pragma unroll
  for (int r = 0; r < 16; ++r) p0[r] = fmaf(p0[r], C, mnC);
#pragma unroll
  for (int r = 0; r < 16; ++r) p1[r] = fmaf(p1[r], C, mnC);
#pragma unroll
  for (int r = 0; r < 16; ++r) p0[r] = __builtin_amdgcn_exp2f(p0[r]);
}
__device__ __forceinline__ void finishSM(f32x16& p0, f32x16& p1, float alpha, float& l_reg, bf16x8& pa0, bf16x8& pa1, bf16x8& pa2, bf16x8& pa3) {
#pragma unroll
  for (int r = 0; r < 16; ++r) p1[r] = __builtin_amdgcn_exp2f(p1[r]);
  float ps = 0;
#pragma unroll
  for (int r = 0; r < 16; ++r) ps += p0[r];
#pragma unroll
  for (int r = 0; r < 16; ++r) ps += p1[r];
  { auto rr = __builtin_amdgcn_permlane32_swap(__float_as_uint(ps), __float_as_uint(ps), false, false);
    ps = __uint_as_float(rr[0]) + __uint_as_float(rr[1]); }
  l_reg = l_reg * alpha + ps;
#define PK4(P, BASE, OUT) do { unsigned a0 = cvtpk(P[BASE + 0], P[BASE + 1]), a1 = cvtpk(P[BASE + 2], P[BASE + 3]);   \
    unsigned b0 = cvtpk(P[BASE + 4], P[BASE + 5]), b1 = cvtpk(P[BASE + 6], P[BASE + 7]);                              \
    auto r0 = __builtin_amdgcn_permlane32_swap(a0, b0, false, false); auto r1 = __builtin_amdgcn_permlane32_swap(a1, b1, false, false); \
    u32x4 w = {r0[0], r1[0], r0[1], r1[1]}; OUT = __builtin_bit_cast(bf16x8, w); } while (0)
  PK4(p0, 0, pa0); PK4(p0, 8, pa1); PK4(p1, 0, pa2); PK4(p1, 8, pa3);
#undef PK4
}
typedef int v8i __attribute__((ext_vector_type(8)));
typedef int v4i __attribute__((ext_vector_type(4)));
__device__ __forceinline__ v8i ld32(const LAS unsigned char* p, int a) { const v4i x = *(const LAS v4i*)(p + a), y = *(const LAS v4i*)(p + (a ^ 16)); return __builtin_shufflevector(x, y, 0, 1, 2, 3, 4, 5, 6, 7); }
template <bool MLA>
__device__ __forceinline__ void qkt(f32x16& p0, f32x16& p1, const LAS unsigned char* Ks, const LAS unsigned char* K2s, const v8i* qr8, int r32, int hi, const f32x16 init = f32x16{}) {
  p0 = init; p1 = init;
  const int sw = (r32 >> 1) & 7, rb = r32 * 128;
#pragma unroll
  for (int st = 0; st < 2; ++st) { const int a = rb + (((4 * st + 2 * hi) ^ sw) * 16);
    const v8i k0 = ld32(Ks, a), k1 = ld32(Ks, a + 32 * 128);
    p0 = __builtin_amdgcn_mfma_scale_f32_32x32x64_f8f6f4(k0, qr8[st], p0, 0, 0, 0, 0x7f7f7f7f, 0, QSCALE_E8);
    p1 = __builtin_amdgcn_mfma_scale_f32_32x32x64_f8f6f4(k1, qr8[st], p1, 0, 0, 0, 0x7f7f7f7f, 0, QSCALE_E8); }
  if constexpr (MLA) { const int a = r32 * 64 + (((2 * hi) ^ ((r32 >> 2) & 3)) * 16);
    const v8i k0 = ld32(K2s, a), k1 = ld32(K2s, a + 32 * 64);
    p0 = __builtin_amdgcn_mfma_scale_f32_32x32x64_f8f6f4(k0, qr8[2], p0, 0, 0, 0, 0x7f7f7f7f, 0, QSCALE_E8);
    p1 = __builtin_amdgcn_mfma_scale_f32_32x32x64_f8f6f4(k1, qr8[2], p1, 0, 0, 0, 0x7f7f7f7f, 0, QSCALE_E8); }
}
__device__ __forceinline__ int v_st(int k, int c) { const int kk = (k & ~0xC) | ((k & 4) << 1) | ((k & 8) >> 1); return ((kk >> 3) * 4 + (c >> 5)) * 512 + ((kk & 7) * 32 + (c & 31)) * 2; }
__device__ __forceinline__ int v_rd_base(int lane) { return ((lane & 3) << 3) | (((lane >> 2) & 3) << 6) | (((lane >> 4) & 1) << 5) | (((lane >> 5) & 1) << 8); }
constexpr int v_rd_off(int d0, int ks, int half) { return d0 * 512 + ks * 4096 + half * 2048; }
template <int OFF> __device__ __forceinline__ s16x4 tr_read(int vb) {
  s16x4 r; asm volatile("ds_read_b64_tr_b16 %0, %1 offset:%2" : "=&v"(r) : "v"(vb), "i"(OFF) : "memory"); return r;
}
template <int D0> __device__ __forceinline__ void pv_one(f32x16& od, int vb, bf16x8 pa0, bf16x8 pa1, bf16x8 pa2, bf16x8 pa3) {
  const s16x4 l0 = tr_read<v_rd_off(D0, 0, 0)>(vb), h0 = tr_read<v_rd_off(D0, 0, 1)>(vb), l1 = tr_read<v_rd_off(D0, 1, 0)>(vb), h1 = tr_read<v_rd_off(D0, 1, 1)>(vb);
  const s16x4 l2 = tr_read<v_rd_off(D0, 2, 0)>(vb), h2 = tr_read<v_rd_off(D0, 2, 1)>(vb), l3 = tr_read<v_rd_off(D0, 3, 0)>(vb), h3 = tr_read<v_rd_off(D0, 3, 1)>(vb);
  asm volatile("s_waitcnt lgkmcnt(0)" ::: "memory"); SBAR();
#define PK(L, H) (bf16x8){L[0], L[1], L[2], L[3], H[0], H[1], H[2], H[3]}
  od = __builtin_amdgcn_mfma_f32_32x32x16_bf16(pa0, PK(l0, h0), od, 0, 0, 0);
  od = __builtin_amdgcn_mfma_f32_32x32x16_bf16(pa1, PK(l1, h1), od, 0, 0, 0);
  od = __builtin_amdgcn_mfma_f32_32x32x16_bf16(pa2, PK(l2, h2), od, 0, 0, 0);
  od = __builtin_amdgcn_mfma_f32_32x32x16_bf16(pa3, PK(l3, h3), od, 0, 0, 0);
#undef PK
}
constexpr float SM_BIG = 2048.f;
__device__ __forceinline__ void expSM(f32x16& p0) {
#pragma unroll
  for (int r = 0; r < 16; ++r) p0[r] = __builtin_amdgcn_exp2f(p0[r]);
}
__device__ __forceinline__ float xhalf_max(float v) { auto rr = __builtin_amdgcn_permlane32_swap(__float_as_uint(v), __float_as_uint(v), false, false); return fmaxf(__uint_as_float(rr[0]), __uint_as_float(rr[1])); }
__device__ __forceinline__ float xhalf_sum(float v) { auto rr = __builtin_amdgcn_permlane32_swap(__float_as_uint(v), __float_as_uint(v), false, false); return __uint_as_float(rr[0]) + __uint_as_float(rr[1]); }
__device__ __forceinline__ void finishSM2(f32x16& p0, f32x16& p1, float& dm, float& l_reg, float& alpha, bool& ovf, bf16x8& pa0, bf16x8& pa1, bf16x8& pa2, bf16x8& pa3) {
#pragma unroll
  for (int r = 0; r < 16; ++r) p1[r] = __builtin_amdgcn_exp2f(p1[r]);
  float ps = 0;
#pragma unroll
  for (int r = 0; r < 16; ++r) ps += p0[r];
#pragma unroll
  for (int r = 0; r < 16; ++r) ps += p1[r];
  ps = xhalf_sum(ps);
  alpha = 1.f; dm = 0.f;
  if (__builtin_expect(!__all(ps <= (SM_TEST == 1 ? 0.5f : SM_BIG)), 0)) {
    asm volatile("");
    float pmax = p0[0];
#pragma unroll
    for (int r = 1; r < 16; ++r) pmax = fmaxf(pmax, p0[r]);
#pragma unroll
    for (int r = 0; r < 16; ++r) pmax = fmaxf(pmax, p1[r]);
    pmax = xhalf_max(pmax);
    if (!(pmax < 1e30f)) ovf = true;
    const bool up = pmax > 1.f; const float sc = up ? __builtin_amdgcn_rcpf(pmax) : 1.f;
    alpha = sc; dm = up ? __builtin_amdgcn_logf(pmax) : 0.f;
#pragma unroll
    for (int r = 0; r < 16; ++r) { p0[r] *= sc; p1[r] *= sc; }
    ps *= sc;
  }
  l_reg = l_reg * alpha + ps;
#define PK4(P, BASE, OUT) do { unsigned a0 = cvtpk(P[BASE + 0], P[BASE + 1]), a1 = cvtpk(P[BASE + 2], P[BASE + 3]);   \
    unsigned b0 = cvtpk(P[BASE + 4], P[BASE + 5]), b1 = cvtpk(P[BASE + 6], P[BASE + 7]);                              \
    auto r0 = __builtin_amdgcn_permlane32_swap(a0, b0, false, false); auto r1 = __builtin_amdgcn_permlane32_swap(a1, b1, false, false); \
    u32x4 w = {r0[0], r1[0], r0[1], r1[1]}; OUT = __builtin_bit_cast(bf16x8, w); } while (0)
  PK4(p0, 0, pa0); PK4(p0, 8, pa1); PK4(p1, 0, pa2); PK4(p1, 8, pa3);
#undef PK4
}
#define PVR(S, D0, VB) const s16x4 S##l0 = tr_read<v_rd_off(D0, 0, 0)>(VB), S##h0 = tr_read<v_rd_off(D0, 0, 1)>(VB), S##l1 = tr_read<v_rd_off(D0, 1, 0)>(VB), S##h1 = tr_read<v_rd_off(D0, 1, 1)>(VB), \
                                    S##l2 = tr_read<v_rd_off(D0, 2, 0)>(VB), S##h2 = tr_read<v_rd_off(D0, 2, 1)>(VB), S##l3 = tr_read<v_rd_off(D0, 3, 0)>(VB), S##h3 = tr_read<v_rd_off(D0, 3, 1)>(VB);
#define PVK(L, H) (bf16x8){L[0], L[1], L[2], L[3], H[0], H[1], H[2], H[3]}
#define PVM(S, OD) OD = __builtin_amdgcn_mfma_f32_32x32x16_bf16(pa0, PVK(S##l0, S##h0), OD, 0, 0, 0); OD = __builtin_amdgcn_mfma_f32_32x32x16_bf16(pa1, PVK(S##l1, S##h1), OD, 0, 0, 0); \
                   OD = __builtin_amdgcn_mfma_f32_32x32x16_bf16(pa2, PVK(S##l2, S##h2), OD, 0, 0, 0); OD = __builtin_amdgcn_mfma_f32_32x32x16_bf16(pa3, PVK(S##l3, S##h3), OD, 0, 0, 0);
#define PV_BEGIN(VB) PVR(a, 0, VB) SBAR();
#define EXP4(P, B0) do { P[B0] = __builtin_amdgcn_exp2f(P[B0]); P[B0 + 1] = __builtin_amdgcn_exp2f(P[B0 + 1]); P[B0 + 2] = __builtin_amdgcn_exp2f(P[B0 + 2]); P[B0 + 3] = __builtin_amdgcn_exp2f(P[B0 + 3]); } while (0)
#define PV_REST(VB) PV_REST_X(VB, PV_NOX, 0)
#define PV_NOX(P, B0) do { } while (0)
#define PV_REST_X(VB, X, XP) \
  PVR(b, 1, VB) \
  asm volatile("s_waitcnt lgkmcnt(8)" ::: "memory"); SBAR(); \
  PVM(a, o[0]) X(XP, 0); SBAR(); \
  PVR(c, 2, VB) \
  asm volatile("s_waitcnt lgkmcnt(8)" ::: "memory"); SBAR(); \
  PVM(b, o[1]) X(XP, 4); SBAR(); \
  PVR(d, 3, VB) \
  asm volatile("s_waitcnt lgkmcnt(8)" ::: "memory"); SBAR(); \
  PVM(c, o[2]) X(XP, 8); SBAR(); \
  asm volatile("s_waitcnt lgkmcnt(0)" ::: "memory"); SBAR(); \
  PVM(d, o[3]) X(XP, 12);
struct UnitArgs { const unsigned char* Q; int ldq; const unsigned char* K1; int ldk1; const unsigned char* K2; int ldk2; const bf16* V; int ldv; bf16* O; float* sso; int nq; float scale; };
template <bool MLA, bool SAFE>
__device__ __forceinline__ bool attn_unit(const UnitArgs& A, LAS unsigned char* lds, int wave_in, int fslot) {
  int tid = wave_in * 64 + lane_id(); asm volatile("" : "+v"(tid));
  const int wid = __builtin_amdgcn_readfirstlane(tid >> 6), lane = tid & 63, r32 = lane & 31, hi = lane >> 5;
  LAS unsigned char* V_lds = lds + OFF_V; LAS unsigned char* K_lds = lds + OFF_K; LAS unsigned char* K2_lds = lds + OFF_K2;
  LAS float* wsf = (LAS float*)(lds + OFF_WS) + wid * 64; LAS float* li_l = wsf; LAS float* al_l = wsf + 32;
  const bool wact = wid * QBLK < A.nq;
  volatile LAS unsigned* oflag = (volatile LAS unsigned*)(lds + ATT_LDS) + fslot;
  if (!SAFE && tid == 0) *oflag = 0u;
  bool ovf = false;
  const int sr = tid >> 4, sc = (tid & 15) * 8, vst0 = v_st(sr, sc), vst1 = v_st(32 + sr, sc);
  const int kr = tid >> 3, kc = tid & 7, kst = kr * 128 + ((kc ^ ((kr >> 1) & 7)) * 16);
  const int k2r = (tid & 255) >> 2, k2c = tid & 3, k2st = k2r * 64 + ((k2c ^ ((k2r >> 2) & 3)) * 16);
  const bool k2w = tid < 256;
  unsigned vo = (unsigned)(sr * A.ldv + sc) * 2u, ko = (unsigned)(kr * A.ldk1 + kc * 16), k2o = (unsigned)(k2r * A.ldk2 + k2c * 16);
  const unsigned v32 = 64u * (unsigned)A.ldv, k64 = 64u * (unsigned)A.ldk1, k2s64 = 64u * (unsigned)A.ldk2;
  const char* Vb = (const char*)A.V; const char* K1b = (const char*)A.K1; const char* K2b = (const char*)A.K2;
  bf16x8 vs0, vs1; v4i ks0, k2s;
#define SLOAD() do { vs0 = *(const bf16x8*)(Vb + vo); vs1 = *(const bf16x8*)(Vb + (vo + v32)); ks0 = *(const v4i*)(K1b + ko); vo += 2 * v32; ko += k64; \
    if (MLA) { if (k2w) k2s = *(const v4i*)(K2b + k2o); k2o += k2s64; } } while (0)
#define SWRITE(b) do { asm volatile("s_waitcnt vmcnt(0)" ::: "memory"); *(LAS bf16x8*)(V_lds + (b) * SHM_V + vst0) = vs0; *(LAS bf16x8*)(V_lds + (b) * SHM_V + vst1) = vs1; \
    *(LAS v4i*)(K_lds + (b) * SHM_K + kst) = ks0; \
    if (MLA) { if (k2w) *(LAS v4i*)(K2_lds + (b) * SHM_K2 + k2st) = k2s; } } while (0)
  if (!wact) {
    SLOAD(); SWRITE(0); __syncthreads();
    SLOAD(); SWRITE(1); __syncthreads();
#pragma unroll 1
    for (int j = 1; j + 1 < NT; j += 2) {
      SLOAD(); __syncthreads(); SWRITE(0); __syncthreads();
      if (j + 2 < NT) SLOAD(); __syncthreads(); if (j + 2 < NT) SWRITE(1); __syncthreads();
    }
    __syncthreads();
  } else {
  const float C = 1.f, thr = 8.f * 1.4426950408889634f;
  float m_reg = -1e30f, l_reg = 0; f32x16 o[4] = {}; v8i qr8[MLA ? 3 : 2];
  { int qrow = wid * QBLK + r32; qrow = qrow < A.nq ? qrow : A.nq - 1;
    const unsigned char* Qw = A.Q + (size_t)qrow * A.ldq + hi * 32;
#pragma unroll
    for (int st = 0; st < (MLA ? 3 : 2); ++st) { const v4i x = __builtin_nontemporal_load((const v4i*)(Qw + st * 64)), y = __builtin_nontemporal_load((const v4i*)(Qw + st * 64 + 16));        qr8[st] = __builtin_shufflevector(x, y, 0, 1, 2, 3, 4, 5, 6, 7); } }
  const int vb0 = (int)(unsigned)(size_t)V_lds + v_rd_base(lane);
#define RESC(a) do { if (__any((a) < 1.f)) { if (hi == 0) al_l[r32] = (a); asm volatile("s_waitcnt lgkmcnt(0)" ::: "memory"); \
    _Pragma("unroll") for (int d = 0; d < 4; ++d) _Pragma("unroll") for (int r = 0; r < 16; ++r) o[d][r] *= al_l[crow(r, hi)]; } } while (0)
  f32x16 pA0, pA1, pB0, pB1; float mnA, mnB, alA = 1.f, alB = 1.f; bf16x8 pa0, pa1, pa2, pa3;
  SLOAD(); SWRITE(0); __syncthreads();
  qkt<MLA>(pA0, pA1, K_lds, K2_lds, qr8, r32, hi); partialSM(pA0, pA1, m_reg, mnA, alA, C, thr);
  SLOAD(); SWRITE(1); __syncthreads();
  f32x16 negm; float dm = 0.f;
  if constexpr (!SAFE) {
#pragma unroll
    for (int r = 0; r < 16; ++r) negm[r] = -m_reg; }
#define BUMP(P0, P1) do { if (__any(dm != 0.f)) { asm volatile(""); _Pragma("unroll") for (int r = 0; r < 16; ++r) { negm[r] -= dm; P0[r] -= dm; P1[r] -= dm; } } } while (0)
#pragma unroll 1
  for (int j = 1; j + 1 < NT; j += 2) {
    SLOAD(); SBAR();
    if constexpr (SAFE) qkt<MLA>(pB0, pB1, K_lds + SHM_K, K2_lds + SHM_K2, qr8, r32, hi); else qkt<MLA>(pB0, pB1, K_lds + SHM_K, K2_lds + SHM_K2, qr8, r32, hi, negm);
    if constexpr (SAFE) {
    { PV_BEGIN(vb0) finishSM(pA0, pA1, alA, l_reg, pa0, pa1, pa2, pa3); SBAR();
      PV_REST(vb0); } partialSM(pB0, pB1, m_reg, mnB, alB, C, thr);
    __syncthreads(); SWRITE(0);
    RESC(alB); __syncthreads();
    } else {
    { finishSM2(pA0, pA1, dm, l_reg, alA, ovf, pa0, pa1, pa2, pa3); BUMP(pB0, pB1); RESC(alA); SBAR();
      PV_BEGIN(vb0) PV_REST_X(vb0, EXP4, pB0); }
    __syncthreads(); SWRITE(0);
    __syncthreads();
    }
    if (j + 2 < NT) SLOAD(); SBAR();
    if constexpr (SAFE) qkt<MLA>(pA0, pA1, K_lds, K2_lds, qr8, r32, hi); else qkt<MLA>(pA0, pA1, K_lds, K2_lds, qr8, r32, hi, negm);
    if (j + 1 == NT - 1) {
      asm volatile("");
#pragma unroll
      for (int r = 8; r < 16; ++r) pA0[r] = -1e30f;
#pragma unroll
      for (int r = 0; r < 16; ++r) pA1[r] = -1e30f; }
    if constexpr (SAFE) {
    { PV_BEGIN(vb0 + SHM_V) finishSM(pB0, pB1, alB, l_reg, pa0, pa1, pa2, pa3); SBAR();
      PV_REST(vb0 + SHM_V); } partialSM(pA0, pA1, m_reg, mnA, alA, C, thr);
    __syncthreads(); if (j + 2 < NT) SWRITE(1);
    RESC(alA); __syncthreads();
    } else {
    { finishSM2(pB0, pB1, dm, l_reg, alB, ovf, pa0, pa1, pa2, pa3); BUMP(pA0, pA1); RESC(alB); SBAR();
      PV_BEGIN(vb0 + SHM_V) PV_REST_X(vb0 + SHM_V, EXP4, pA0); }
    __syncthreads(); if (j + 2 < NT) SWRITE(1);
    __syncthreads();
    }
  }
  {
    if constexpr (SAFE) { PV_BEGIN(vb0) finishSM(pA0, pA1, alA, l_reg, pa0, pa1, pa2, pa3); SBAR();
      PV_REST(vb0); }
    else { finishSM2(pA0, pA1, dm, l_reg, alA, ovf, pa0, pa1, pa2, pa3); RESC(alA); SBAR();
      PV_BEGIN(vb0) PV_REST(vb0); }
    if (!SAFE && (__any(ovf) || SM_TEST == 2) && lane == 0) *oflag = 1u;
    if (hi == 0) li_l[r32] = l_reg; asm volatile("s_waitcnt lgkmcnt(0)" ::: "memory");
    int r32e = r32, hie = hi; asm volatile("" : "+v"(r32e), "+v"(hie));
    LAS unsigned char* ost = lds + OFF_OST + wid * OST_WAVE;
#pragma unroll
    for (int r = 0; r < 16; ++r) { const int orow = crow(r, hie); const bool ok = wid * QBLK + orow < A.nq; float s = 0.f; const float rl = __builtin_amdgcn_rcpf(li_l[orow]);
#pragma unroll
      for (int d0 = 0; d0 < 4; ++d0) { const float v = o[d0][r] * rl; s += v * v; *(LAS bf16*)(ost + orow * OST_PITCH + (d0 * 32 + r32e) * 2) = (bf16)cvtpk(v, v); }
      s += __shfl_xor(s, 1); s += __shfl_xor(s, 2); s += __shfl_xor(s, 4); s += __shfl_xor(s, 8); s += __shfl_xor(s, 16);
      if (ok && r32e == 0) A.sso[(size_t)(wid * QBLK + orow) * 16] = s; }
    asm volatile("s_waitcnt lgkmcnt(0)" ::: "memory");
    { const int lane_e = r32e + 32 * hie; bf16* Ob = A.O + (size_t)(wid * QBLK) * 2048 + (lane_e & 15) * 8;
#pragma unroll
      for (int i = 0; i < 8; ++i) { const int orow = 4 * i + (lane_e >> 4); const u32x4 w = *(const LAS u32x4*)(ost + orow * OST_PITCH + (lane_e & 15) * 16);
        if (wid * QBLK + orow < A.nq) *(u32x4*)(Ob + (size_t)orow * 2048) = w; } }
  }
  __syncthreads();
#undef RESC
#undef BUMP
  }
#undef SLOAD
#undef SWRITE
  return SAFE ? false : (*oflag != 0u);
}
__device__ __forceinline__ void attn_phase(LAS unsigned char* lds, int wave_in, int G, int vcu, const unsigned char* QM8, const unsigned char* GQ8, const unsigned char* GK8, const unsigned char* KN8, const unsigned char* KR8, const bf16* KVB, const bf16* U, bf16* OA, float* sso) {
  for (int i = 0;; ++i) {
    const int id = i * G + vcu; if (id >= 9 * 256) break;
    const int r = id >> 8, v = id & 255, b = v >> 4, c = v & 15;
    int head16, qt;
    if (r < 4) { head16 = c >> 1; qt = (c & 1) * 4 + r; } else if (r < 8) { head16 = 8 + (c >> 1); qt = (c & 1) * 4 + r - 4; } else { head16 = c; qt = 8; }
    const bool mla = head16 < 8; const int h = head16 & 7; const size_t row0 = (size_t)b * T, q0 = row0 + (size_t)qt * 256;
    UnitArgs A;
    A.nq = (T - qt * 256) < 256 ? (T - qt * 256) : 256; A.scale = mla ? MLA_SCALE : GQA_SCALE;
    A.Q = mla ? QM8 + q0 * 1536 + h * QKH : GQ8 + q0 * 1024 + h * GD; A.ldq = mla ? 1536 : 1024;
    A.K1 = mla ? KN8 + row0 * 1024 + h * 128 : GK8 + row0 * 256 + (h >> 2) * GD; A.ldk1 = mla ? 1024 : 256;
    A.K2 = KR8 + row0 * 64; A.ldk2 = 64;
    A.V = mla ? KVB + row0 * 2048 + 1024 + h * 128 : U + row0 * UC + U_GV + (h >> 2) * GD; A.ldv = mla ? 2048 : UC;
    A.O = OA + q0 * 2048 + head16 * 128; A.sso = sso + q0 * 16 + head16;
    const bool redo = mla ? attn_unit<true, false>(A, lds, wave_in, i & 1) : attn_unit<false, false>(A, lds, wave_in, i & 1);
    if (redo) { if (mla) attn_unit<true, true>(A, lds, wave_in, i & 1); else attn_unit<false, true>(A, lds, wave_in, i & 1); }
  }
}
#undef KSWZ
#undef KSWZ2
#undef SBAR
}

__device__ __forceinline__ void tr_item(const float* W, int ldn, int n0, int k0, const float* gain, bf16* WT, int ldk, int r0, LAS float* scr, int lane) {
#pragma unroll 8
    for (int i = 0; i < 32; ++i) { const int kk = 2 * i + (lane >> 5); float v = 0.f;
        if (n0 >= 0) { v = __builtin_nontemporal_load(W + (size_t)(k0 + kk) * ldn + n0 + (lane & 31)); if (gain) v *= gain[kk]; }
        scr[kk * 33 + (lane & 31)] = v; }
    asm volatile("s_waitcnt lgkmcnt(0)" ::: "memory");
    const int c = lane & 7;
#pragma unroll
    for (int j = 0; j < 4; ++j) { const int n = (lane >> 3) + 8 * j; const LAS float* s = scr + (8 * c) * 33 + n;
        u32x4 o; o.x = pk2(s[0 * 33], s[1 * 33]); o.y = pk2(s[2 * 33], s[3 * 33]); o.z = pk2(s[4 * 33], s[5 * 33]); o.w = pk2(s[6 * 33], s[7 * 33]);
        *(u32x4*)(WT + (size_t)(r0 + n) * ldk + k0 + 8 * c) = o; }
    asm volatile("s_waitcnt lgkmcnt(0)" ::: "memory");
}
__device__ __forceinline__ void tr_item8(const float* W, int ldn, int n0, int k0, float scale, unsigned char* WT, int ldk, int r0, LAS float* scr, int lane) {
#pragma unroll 8
    for (int i = 0; i < 32; ++i) { const int kk = 2 * i + (lane >> 5); scr[kk * 33 + (lane & 31)] = __builtin_nontemporal_load(W + (size_t)(k0 + kk) * ldn + n0 + (lane & 31)) * scale; }
    asm volatile("s_waitcnt lgkmcnt(0)" ::: "memory");
#pragma unroll
    for (int j = 0; j < 2; ++j) { const int q = lane + 64 * j, n = q >> 2, c = q & 3; const LAS float* sp = scr + (16 * c) * 33 + n;
        u32x4 o; o.x = pack4_fp8(sp[0 * 33], sp[1 * 33], sp[2 * 33], sp[3 * 33]); o.y = pack4_fp8(sp[4 * 33], sp[5 * 33], sp[6 * 33], sp[7 * 33]);
        o.z = pack4_fp8(sp[8 * 33], sp[9 * 33], sp[10 * 33], sp[11 * 33]); o.w = pack4_fp8(sp[12 * 33], sp[13 * 33], sp[14 * 33], sp[15 * 33]);
        *(u32x4*)(WT + (size_t)(r0 + n) * ldk + k0 + 16 * c) = o; }
    asm volatile("s_waitcnt lgkmcnt(0)" ::: "memory");
}
constexpr int CI_WIN = (UC / 32) * (DM / 64), CI_WQB = (1536 / 32) * (QL / 64), CI_WKVB = (2048 / 32) * (KVL / 64), CI_WOUT = (2048 / 32) * (2048 / 64),
              CI_G = NE * (EFF / 32) * (DM / 64), CI_D = NE * (DM / 32) * (EFF / 64), CI_LAYER = CI_WIN + CI_WQB + CI_WKVB + CI_WOUT + 2 * CI_G + CI_D;
struct ConvPtrs { const float *w_in, *g_q_lora, *w_q_b, *g_kv_lora, *w_kv_b, *g_out_mla, *g_out_gqa, *w_out, *w_gate, *w_up, *w_down; unsigned char* wt; };
__device__ __forceinline__ void conv_item(int it, const ConvPtrs& P, LAS float* scr, int lane) {
    const int l = it / CI_LAYER; int r = it % CI_LAYER; unsigned char* wl = P.wt + (size_t)l * WL_SIZE;
    if (r < CI_WIN) { const int g = r / (DM / 64), kb = r % (DM / 64); tr_item(P.w_in + (size_t)l * DM * INC, INC, ucol_to_ref(32 * g), 64 * kb, nullptr, (bf16*)(wl + WL_WIN), DM, 32 * g, scr, lane); return; } r -= CI_WIN;
    if (r < CI_WQB) { const int g = r / (QL / 64), kb = r % (QL / 64); int n0;
        if (g < 32) { const int r0 = 32 * g; n0 = (r0 / 128) * QKH + (r0 % 128); } else { const int rr = 32 * (g - 32), t = rr / 256, bj = (rr % 256) / 128, hh = (rr % 128) / 32; n0 = (4 * t + hh) * QKH + NOPE + 32 * bj; }
        tr_item(P.w_q_b + (size_t)l * QL * 1536, 1536, n0, 64 * kb, P.g_q_lora + l * QL + 64 * kb, (bf16*)(wl + WL_WQB), QL, 32 * g, scr, lane); return; } r -= CI_WQB;
    if (r < CI_WKVB) { const int g = r / (KVL / 64), kb = r % (KVL / 64); const int r0 = 32 * g; const int n0 = r0 < 1024 ? (r0 / 128) * 256 + (r0 % 128) : ((r0 - 1024) / 128) * 256 + 128 + ((r0 - 1024) % 128);
        tr_item(P.w_kv_b + (size_t)l * KVL * 2048, 2048, n0, 64 * kb, P.g_kv_lora + l * KVL + 64 * kb, (bf16*)(wl + WL_WKVB), KVL, r0, scr, lane); return; } r -= CI_WKVB;
    if (r < CI_WOUT) { const int g = r / 32, kb = r % 32; const int k0 = 64 * kb; const float* gain = k0 < 1024 ? P.g_out_mla + l * 1024 + k0 : P.g_out_gqa + l * 1024 + (k0 - 1024);
        tr_item(P.w_out + (size_t)l * 2048 * DM, DM, 32 * g, k0, gain, (bf16*)(wl + WL_WOUT), 2048, 32 * g, scr, lane); return; } r -= CI_WOUT;
    if (r < 2 * CI_G) { const int up = r >= CI_G; if (up) r -= CI_G; const int e = r / ((EFF / 32) * (DM / 64)), rr = r % ((EFF / 32) * (DM / 64)), g = rr / (DM / 64), kb = rr % (DM / 64);
        const int c0 = 32 * g; const int r0 = 256 * (c0 / 128) + (c0 % 128) + (up ? 128 : 0);
        if (MOE_F8_GU) tr_item8((up ? P.w_up : P.w_gate) + ((size_t)l * NE + e) * DM * EFF, EFF, c0, 64 * kb, WSCALE8, wl + WL_WGU + (size_t)e * 2048 * 2048, DM, r0, scr, lane);
        else tr_item((up ? P.w_up : P.w_gate) + ((size_t)l * NE + e) * DM * EFF, EFF, c0, 64 * kb, nullptr, (bf16*)(wl + WL_WGU) + (size_t)e * 2048 * 2048, DM, r0, scr, lane);
        return; } r -= 2 * CI_G;
    { const int e = r / ((DM / 32) * (EFF / 64)), rr = r % ((DM / 32) * (EFF / 64)), g = rr / (EFF / 64), kb = rr % (EFF / 64);
      if (MOE_F8_DN) tr_item8(P.w_down + ((size_t)l * NE + e) * EFF * DM, DM, 32 * g, 64 * kb, WDSCALE8, wl + WL_WD + (size_t)e * 2048 * 1024, EFF, 32 * g, scr, lane);
      else tr_item(P.w_down + ((size_t)l * NE + e) * EFF * DM, DM, 32 * g, 64 * kb, nullptr, (bf16*)(wl + WL_WD) + (size_t)e * 2048 * 1024, EFF, 32 * g, scr, lane); }
}

template <int PMODE = 0>
__device__ __forceinline__ void route_rows2(int m, int m_next, u32x2 (&r0)[8], u32x2 (&r1)[8], const bf16* Z, bf16* H1, unsigned char* H1Q, const float* g, const float* b, const LAS float* wr, const float* rbias, int* eidx, float* wts, LAS unsigned* lcnt, LAS unsigned* stash, int lane) {
    f32x4 v0[8], v1[8]; unpack_row(r0, v0); unpack_row(r1, v1);
    ln_apply(v0, g, b, lane); ln_apply(v1, g, b, lane);
    __builtin_amdgcn_sched_barrier(0);
    { const int mn = m_next >= 0 ? m_next : m; load_row_raw(Z + (size_t)mn * DM, r0, lane); load_row_raw(Z + (size_t)(mn + 1) * DM, r1, lane); }
    __builtin_amdgcn_sched_barrier(0);
    if (!(PMODE & 2)) { store_row_bf16_nt(H1 + (size_t)m * DM, v0, lane); store_row_bf16_nt(H1 + (size_t)(m + 1) * DM, v1, lane);
    if (H1Q) { store_row_fp8(H1Q + (size_t)m * DM, v0, lane); store_row_fp8(H1Q + (size_t)(m + 1) * DM, v1, lane); } }
    float a[32];
    f32x4 wA[4], wB[4];
#define RD4(W, E_, H_) { const LAS float* wre = wr + (E_) * 2048 + (H_) * 1024 + 4 * lane; asm volatile("" : "+v"(wre)); _Pragma("unroll") for (int j = 0; j < 4; ++j) W[j] = *(const LAS f32x4*)(wre + 256 * j); }
#define FMAC(ACC, X, W_) asm("v_fmac_f32 %0, %1, %2" : "+v"(ACC) : "v"(X), "v"(W_))
#define FM4(W, H_) { _Pragma("unroll") for (int j = 0; j < 4; ++j) { FMAC(s0, v0[4 * (H_) + j][0], W[j].x); FMAC(t0, v1[4 * (H_) + j][0], W[j].x); FMAC(s1, v0[4 * (H_) + j][1], W[j].y); FMAC(t1, v1[4 * (H_) + j][1], W[j].y); FMAC(s0, v0[4 * (H_) + j][2], W[j].z); FMAC(t0, v1[4 * (H_) + j][2], W[j].z); FMAC(s1, v0[4 * (H_) + j][3], W[j].w); FMAC(t1, v1[4 * (H_) + j][3], W[j].w); } }
    if (PMODE & 1) {
#pragma unroll
        for (int e = 0; e < 16; ++e) { a[e] = v0[e & 7][e >> 3]; a[16 + e] = v1[e & 7][e >> 3]; }
    } else {
        RD4(wA, 0, 0)
#pragma unroll
        for (int e = 0; e < 16; ++e) { float s0 = 0.f, s1 = 0.f, t0 = 0.f, t1 = 0.f;
            RD4(wB, e, 1) __builtin_amdgcn_sched_barrier(0);
            FM4(wA, 0) __builtin_amdgcn_sched_barrier(0);
            if (e + 1 < 16) RD4(wA, e + 1, 0) __builtin_amdgcn_sched_barrier(0);
            FM4(wB, 1) __builtin_amdgcn_sched_barrier(0);
            a[e] = s0 + s1; a[16 + e] = t0 + t1; }
    }
#undef RD4
#undef FM4
#undef FMAC
#define RSTEP(N, MASK) _Pragma("unroll") for (int i = 0; i < (N) / 2; ++i) { const bool up = (lane & (MASK)) != 0; const float send = up ? a[i] : a[(N) / 2 + i]; const float keep = up ? a[(N) / 2 + i] : a[i]; a[i] = keep + __shfl_xor(send, (MASK)); }
    RSTEP(32, 32) RSTEP(16, 16) RSTEP(8, 8) RSTEP(4, 4) RSTEP(2, 2)
#undef RSTEP
    const float tot = a[0] + __shfl_xor(a[0], 1);
    const int e_me = (lane >> 1) & 15, ei = e_me & 3, gi = e_me >> 2;
    const float sc = 1.f / (1.f + __expf(-tot)); const float sel = sc + rbias[e_me];
    const float s1 = __shfl_xor(sel, 2), s2 = __shfl_xor(sel, 4), s3 = __shfl_xor(s1, 4);
    const float hi1 = fmaxf(sel, s1), lo1 = fminf(sel, s1), hi2 = fmaxf(s2, s3), lo2 = fminf(s2, s3);
    const float gsc = fmaxf(hi1, hi2) + fmaxf(fminf(hi1, hi2), fmaxf(lo1, lo2));
    const float g1 = __shfl_xor(gsc, 8), g2 = __shfl_xor(gsc, 16), g3 = __shfl_xor(g1, 16);
    bool win = true;
    win = win && (((gi ^ 1) < gi) ? (gsc > g1) : (gsc >= g1));
    win = win && (((gi ^ 2) < gi) ? (gsc > g2) : (gsc >= g2));
    win = win && (((gi ^ 3) < gi) ? (gsc > g3) : (gsc >= g3));
    int rank = 0;
    rank += (s1 > sel || (s1 == sel && (ei ^ 1) < ei)) ? 1 : 0;
    rank += (s2 > sel || (s2 == sel && (ei ^ 2) < ei)) ? 1 : 0;
    rank += (s3 > sel || (s3 == sel && (ei ^ 3) < ei)) ? 1 : 0;
    const unsigned long long mk1 = __builtin_amdgcn_ballot_w64(win && rank == 0 && !(lane & 1)), mk2 = __builtin_amdgcn_ballot_w64(win && rank == 1 && !(lane & 1));
    const int l1a = __builtin_ctz((unsigned)mk1 | 0x80000000u), l2a = __builtin_ctz((unsigned)mk2 | 0x80000000u);
    const int l1b = 32 + __builtin_ctz((unsigned)(mk1 >> 32) | 0x80000000u), l2b = 32 + __builtin_ctz((unsigned)(mk2 >> 32) | 0x80000000u);
    const int ea = l1a >> 1, eb = l2a >> 1, ec = (l1b >> 1) & 15, ed = (l2b >> 1) & 15;
    const int sci = __builtin_bit_cast(int, sc);
    const float w1a = __builtin_bit_cast(float, __builtin_amdgcn_readlane(sci, l1a)), w2a = __builtin_bit_cast(float, __builtin_amdgcn_readlane(sci, l2a));
    const float w1b = __builtin_bit_cast(float, __builtin_amdgcn_readlane(sci, l1b)), w2b = __builtin_bit_cast(float, __builtin_amdgcn_readlane(sci, l2b));
    if (lane == 0) { const float ia = 1.f / (w1a + w2a), ib = 1.f / (w1b + w2b);
        eidx[2 * m] = ea; eidx[2 * m + 1] = eb; eidx[2 * m + 2] = ec; eidx[2 * m + 3] = ed;
        wts[2 * m] = w1a * ia; wts[2 * m + 1] = w2a * ia; wts[2 * m + 2] = w1b * ib; wts[2 * m + 3] = w2b * ib; }
    if (lane < 4) { const int e = lane == 0 ? ea : lane == 1 ? eb : lane == 2 ? ec : ed;
        const unsigned r = __hip_atomic_fetch_add(lcnt + e, 1u, __ATOMIC_RELAXED, __HIP_MEMORY_SCOPE_WORKGROUP); stash[lane] = ((unsigned)e << 24) | r; }
}

#ifndef FILLER
#define FILLER 1
#endif
constexpr int FILL_D1 = 0, FILL_F1 = 7000, FILL_G1 = 11000;
constexpr int MM = M - 256;
constexpr int XB_Q = 10, XB_KV = 16, XB_LEND = 24;
constexpr int NXA = 10, NXD = 8;
struct Args { const float* in[23]; float* out; unsigned char* ws; int l_lo, l_hi, ph_lo, ph_hi, prologue, use_bar, pad0, pad1; };
__global__ void __launch_bounds__(NWAVES * 64, 2) fwd(Args args) {
    extern __shared__ __attribute__((aligned(16))) unsigned char lds_raw[];
    LAS unsigned char* lds = (LAS unsigned char*)lds_raw;
    volatile LAS unsigned* LC = (volatile LAS unsigned*)(lds + LDSCTL_OFF);
    const int wave = __builtin_amdgcn_readfirstlane(threadIdx.x >> 6);
#define lane lane_id()
#define tid (wave * 64 + lane_id())
    const int G = gridDim.x; const int bx = blockIdx.x; const int vcu = (G % 8 == 0) ? (bx % 8) * (G / 8) + bx / 8 : bx;
    const int gw = vcu * NWAVES + wave, NGW = G * NWAVES;
    unsigned char* ws = (unsigned char*)(GAS unsigned char*)args.ws;
    for (int u = tid; u < (LDS_BYTES - LDSCTL_OFF) / 4; u += NWAVES * 64) LC[u] = 0u;
    __syncthreads();
    XcdBarrier bar; bar.bar = (unsigned*)(ws + WS_CTL) + CW_BAR; bar.x = 0; bar.st = nullptr;
    if (!FLEX || args.use_bar) { bar = xcd_barrier_post((unsigned*)(ws + WS_CTL) + CW_BAR, LC + LC_BAR); if (threadIdx.x == 0) LC[LC_BAR + 2] = bar.x; bar.x = 0; }
#define SEAM() do { if (!FLEX || args.use_bar) { XcdBarrier b2_ = bar; b2_.x = LC[LC_BAR + 2]; GAS unsigned* bp_ = (GAS unsigned*)b2_.bar; asm volatile("" : "+s"(bp_)); b2_.bar = (unsigned*)bp_; xcd_barrier(b2_, wave == 0 && lane_id() == 0); if ((REP_MASK >> 11) & 1) xcd_barrier(b2_, wave == 0 && lane_id() == 0); } } while (0)
#define CAS __attribute__((address_space(4)))
#define GIN(k) ((const float*)(const GAS float*)ap_->in[k])
#define PHASE_PTRS() const CAS Args* ap_ = (const CAS Args*)__builtin_amdgcn_kernarg_segment_ptr(); asm volatile("" : "+s"(ap_));   \
    GAS unsigned char* wsp = (GAS unsigned char*)ap_->ws; int ptid = wave * 64 + lane_id(); asm volatile("" : "+v"(ptid)); const int plane = ptid & 63; (void)plane; \
    int pG = G, pbx = bx, pvcu = vcu, pgw = gw, pNGW = NGW; asm volatile("" : "+s"(pG), "+s"(pbx), "+s"(pvcu), "+s"(pgw), "+s"(pNGW)); (void)pG; (void)pbx; (void)pvcu; (void)pgw; (void)pNGW;   \
    float* cosA = (float*)(wsp + OFF_COSA); float* sinA = (float*)(wsp + OFF_SINA); float* cosB = (float*)(wsp + OFF_COSB); float* sinB = (float*)(wsp + OFF_SINB); \
    bf16* H = (bf16*)(wsp + WS_H); bf16* U = (bf16*)(wsp + WS_U); bf16* QM = (bf16*)(wsp + WS_QM); bf16* KVB = (bf16*)(wsp + WS_KVB); bf16* Y = (bf16*)(wsp + WS_Y); \
    bf16* OA = (bf16*)(wsp + WS_OA); bf16* HE = (bf16*)(wsp + WS_HE); bf16* Z = (bf16*)(wsp + WS_Z); bf16* H1 = (bf16*)(wsp + WS_H1); \
    int* eidx = (int*)(wsp + OFF_EIDX); float* wts = (float*)(wsp + OFF_WTS); int* list = (int*)(wsp + OFF_LIST); \
    float* ssq = (float*)(wsp + OFF_SSQ); float* sskv = (float*)(wsp + OFF_SSKV); float* sso = (float*)(wsp + OFF_SSO); \
    unsigned* cnt = (unsigned*)(wsp + OFF_CNT) + 64 * l; const unsigned char* wl = (const unsigned char*)(wsp + WS_WT + (size_t)l * WL_SIZE); \
    (void)cosA; (void)sinA; (void)cosB; (void)sinB; (void)H; (void)U; (void)QM; (void)KVB; (void)Y; (void)OA; (void)HE; (void)Z; (void)H1; (void)eidx; (void)wts; (void)list; (void)ssq; (void)sskv; (void)sso; (void)cnt; (void)wl

    if (((PH_MASK >> 8) & 1) && (!FLEX || args.prologue)) {
        const int l = 0; PHASE_PTRS();
        const float* x = GIN(0); const float* meta = GIN(1); const float* ln_in_g = GIN(2); const float* ln_in_b = GIN(3);
        ConvPtrs P{GIN(4), GIN(5), GIN(6), GIN(7), GIN(8), GIN(11), GIN(12), GIN(13), GIN(18), GIN(19), GIN(20), (unsigned char*)(wsp + WS_WT)};
        LAS float* scr = (LAS float*)(lds + wave * 16384);
        if (!FLEX || (args.prologue & 1)) for (int rep = 0; rep < NREP(8); ++rep) for (int it = pgw; it < DEPTH * CI_LAYER; it += pNGW) { if (FILLER && it >= CI_LAYER && (it % CI_LAYER) < FILL_G1) continue; conv_item(it, P, scr, plane); }
        if (!FLEX || (args.prologue & 2)) {
            for (int i = (pvcu * NWAVES * 64) + ptid; i < T * 96; i += pG * NWAVES * 64) {
                const int t = i / 96, j = i % 96;
                const float prow = t < NMETA ? -1.f : (float)((t - NMETA) / 64), pcol = t < NMETA ? (float)t : (float)((t - NMETA) % 64);
                float ang;
                if (j < 32) ang = (j < 16 ? prow : pcol) * INV16[j & 15];
                else { const int jj = j - 32; ang = (jj < 32 ? prow : pcol) * INV32[jj & 31]; }
                double s, c; sincos_d((double)ang, s, c);
                if (j < 32) { cosA[t * 32 + j] = (float)c; sinA[t * 32 + j] = (float)s; }
                else { cosB[t * 64 + j - 32] = (float)c; sinB[t * 64 + j - 32] = (float)s; }
            }
            { const float* w_router = GIN(16); float* wrt = (float*)(wsp + OFF_WRT); for (int i = (pvcu * NWAVES * 64) + ptid; i < 16 * 2048; i += pG * NWAVES * 64) { const int e = i >> 11, k = i & 2047; wrt[i] = w_router[k * 16 + e]; } }
            { const int ln = plane; for (int m = pgw; m < M; m += pNGW) ln_in_row(m, x, meta, ln_in_g, ln_in_b, H, ln); }
        }
        SEAM();
    }

#define FILL(nunits, cc, ilo, ihi) do { if (FILLER && l + 1 < DEPTH) { const int rem_ = (nunits) % pG; if ((cc) >= rem_) {     \
        ConvPtrs P{GIN(4), GIN(5), GIN(6), GIN(7), GIN(8), GIN(11), GIN(12), GIN(13), GIN(18), GIN(19), GIN(20), (unsigned char*)(wsp + WS_WT)}; \
        LAS float* scr = (LAS float*)(lds + wave * 16384); const int nw_ = (pG - rem_) * NWAVES; \
        for (int it = (ilo) + ((cc) - rem_) * NWAVES + wave; it < (ihi); it += nw_) conv_item((l + 1) * CI_LAYER + it, P, scr, plane); } } } while (0)
    const int lo = args.ph_lo, hi = args.ph_hi;
#ifndef PH_MASK
#define PH_MASK 0xFFF
#endif
#if FLEX
#define IN(k) (((PH_MASK >> (k)) & 1) && lo <= (k) && (k) < hi)
#else
#define IN(k) ((PH_MASK >> (k)) & 1)
#endif
    for (int l = FLEX ? args.l_lo : 0; l < (FLEX ? args.l_hi : DEPTH); ++l) {
        if (IN(0)) for (int pass = -(int)((REP_MASK >> 0) & 1); pass < 2; ++pass) {
            PHASE_PTRS();
            pg8::DenseSched S; S.init(MM, UC, pG, pbx, DM, DM, (const bf16*)(wl + WL_WIN), (pass == 1 && pbx < NXA) ? pbx : -1, pass <= 0);
            pg8::EpiA E{U, ssq, sskv};
            pg8::gemm_phase<false>(lds, LC + LC_TAB, wave, H, DM, S, E);
            if (pass <= 0) SEAM();
        }
        if (IN(1)) for (int rep = 0; rep < NREP(1); ++rep) {
            PHASE_PTRS(); const float* g_qk_q = GIN(9); const float* g_qk_k = GIN(10);
            const int ln = plane;
            if (pbx < NXA) {
                xsync((unsigned*)(wsp + OFF_CNT) + 64 * (8 + 2 * l), NXA, (unsigned*)(wsp + WS_CTL) + CW_BAR + XB_TMO, ptid == 0);
                for (int m = MM + pbx * NWAVES + wave; m < M; m += NXA * NWAVES) { asm volatile("" ::: "memory"); rowprep_fast(U + (size_t)m * UC, m, (unsigned char*)(wsp + WS_GQ8), (unsigned char*)(wsp + WS_GK8), (unsigned char*)(wsp + WS_KR8), g_qk_q + l * GD, g_qk_k + l * GD, cosA, sinA, cosB, sinB, ln); }
            } else {
                for (int m = (pbx - NXA) * NWAVES + wave; m < MM; m += (pG - NXA) * NWAVES) { asm volatile("" ::: "memory"); rowprep_fast(U + (size_t)m * UC, m, (unsigned char*)(wsp + WS_GQ8), (unsigned char*)(wsp + WS_GK8), (unsigned char*)(wsp + WS_KR8), g_qk_q + l * GD, g_qk_k + l * GD, cosA, sinA, cosB, sinB, ln); }
            }
            { pg8::DenseSched S; S.init(MM, 1536, pG, pbx, UC, QL, (const bf16*)(wl + WL_WQB), -1, 1); pg8::EpiQ E{(unsigned char*)(wsp + WS_QM8), ssq, cosA, sinA}; pg8::gemm_phase<false>(lds, LC + LC_TAB, wave, U + U_CQ, QL, S, E); }
            __syncthreads();
            { pg8::DenseSched S; S.init(MM, 2048, pG, pbx, UC, KVL, (const bf16*)(wl + WL_WKVB), -1, 1); S.lendN = ((MM / 256 * 8) % pG == 0 && pG >= XB_LEND + NXA) ? NXA : 0; S.lendB = XB_LEND;
              pg8::EpiKV E{KVB, (unsigned char*)(wsp + WS_KN8), sskv}; pg8::gemm_phase<false>(lds, LC + LC_TAB, wave, U + U_CKV, KVL, S, E); }
            if (pbx >= XB_Q && pbx < XB_Q + 6) { xwait((unsigned*)(wsp + OFF_CNT) + 64 * (8 + 2 * l), NXA, (unsigned*)(wsp + WS_CTL) + CW_BAR + XB_TMO, ptid == 0);
                pg8::DenseSched S; S.init(MM, 1536, pG, pbx, UC, QL, (const bf16*)(wl + WL_WQB), pbx - XB_Q, 0); pg8::EpiQ E{(unsigned char*)(wsp + WS_QM8), ssq, cosA, sinA}; pg8::gemm_phase<false>(lds, LC + LC_TAB, wave, U + U_CQ, QL, S, E); }
            if (pbx >= XB_KV && pbx < XB_KV + 8) { xwait((unsigned*)(wsp + OFF_CNT) + 64 * (8 + 2 * l), NXA, (unsigned*)(wsp + WS_CTL) + CW_BAR + XB_TMO, ptid == 0);
                pg8::DenseSched S; S.init(MM, 2048, pG, pbx, UC, KVL, (const bf16*)(wl + WL_WKVB), pbx - XB_KV, 0); pg8::EpiKV E{KVB, (unsigned char*)(wsp + WS_KN8), sskv}; pg8::gemm_phase<false>(lds, LC + LC_TAB, wave, U + U_CKV, KVL, S, E); }
            SEAM();
        }
        if (IN(2)) for (int rep = 0; rep < NREP(2); ++rep) {
            PHASE_PTRS();
            att::attn_phase(lds, wave, pG, pvcu, (const unsigned char*)(wsp + WS_QM8), (const unsigned char*)(wsp + WS_GQ8), (const unsigned char*)(wsp + WS_GK8), (const unsigned char*)(wsp + WS_KN8), (const unsigned char*)(wsp + WS_KR8), KVB, U, OA, sso);
            SEAM();
        }
        if (IN(3)) for (int pass = -(int)((REP_MASK >> 3) & 1); pass < 2; ++pass) {
            PHASE_PTRS();
            pg8::DenseSched S; S.init(MM, 2048, pG, pbx, 2048, 2048, (const bf16*)(wl + WL_WOUT), (pass == 1 && pbx < NXD) ? pbx : -1, pass <= 0);
            pg8::EpiD E{Z, H, sso};
            pg8::gemm_phase<false>(lds, LC + LC_TAB, wave, OA, 2048, S, E);
            if (pass <= 0) SEAM();
        }
        if (IN(4)) {
            PHASE_PTRS(); const float* ln1_g = GIN(14); const float* ln1_b = GIN(15); const float* router_bias = GIN(17);
            if (pbx < NXD) xsync((unsigned*)(wsp + OFF_CNT) + 64 * (9 + 2 * l), NXD, (unsigned*)(wsp + WS_CTL) + CW_BAR + XB_TMO, ptid == 0);
            LAS float* wrl = (LAS float*)lds; const int ln = plane;
            { const int td = ptid; const f32x4* wrt = (const f32x4*)(wsp + OFF_WRT); for (int i = td; i < 2048 * 16 / 4; i += NWAVES * 64) ((LAS f32x4*)wrl)[i] = wrt[i]; }
            __syncthreads();
            LAS unsigned* lcnt = (LAS unsigned*)(lds + LDSCTL_OFF) + LC_ECNT; LAS unsigned* lbase = lcnt + 16; LAS unsigned* stash = (LAS unsigned*)(lds + LDSCTL_OFF) + LC_STASH + wave * 128;
            const int m_lo = pbx < NXD ? MM + 2 * (pbx * NWAVES + wave) : 2 * ((pbx - NXD) * NWAVES + wave);
            const int m_hi = pbx < NXD ? M : MM, m_st = pbx < NXD ? 2 * NXD * NWAVES : 2 * (pG - NXD) * NWAVES;
            if ((REP_MASK >> 10) & 1) { int it = 0; LAS unsigned* lcnt2 = (LAS unsigned*)(lds + LDSCTL_OFF) + 2048; LAS unsigned* stash2 = (LAS unsigned*)(lds + LDSCTL_OFF) + 2112 + wave * 128;
              u32x2 r0[8], r1[8]; load_row_raw(Z + (size_t)m_lo * DM, r0, ln); load_row_raw(Z + (size_t)(m_lo + 1) * DM, r1, ln);
#pragma unroll 1
              for (int m = m_lo; m < m_hi; m += m_st, ++it) { asm volatile("" ::: "memory"); route_rows2<PROBE_MODE>(m, m + m_st < m_hi ? m + m_st : -1, r0, r1, Z, H1, MOE_F8_GU ? (unsigned char*)(wsp + WS_H1Q) : (unsigned char*)nullptr, ln1_g + l * DM, ln1_b + l * DM, wrl, router_bias, eidx, wts, lcnt2, stash2 + 4 * it, ln); } }
            { int it = 0;
              u32x2 r0[8], r1[8]; load_row_raw(Z + (size_t)m_lo * DM, r0, ln); load_row_raw(Z + (size_t)(m_lo + 1) * DM, r1, ln);
#pragma unroll 1
              for (int m = m_lo; m < m_hi; m += m_st, ++it) { asm volatile("" ::: "memory"); route_rows2(m, m + m_st < m_hi ? m + m_st : -1, r0, r1, Z, H1, MOE_F8_GU ? (unsigned char*)(wsp + WS_H1Q) : (unsigned char*)nullptr, ln1_g + l * DM, ln1_b + l * DM, wrl, router_bias, eidx, wts, lcnt, stash + 4 * it, ln); } }
            __syncthreads();
            if (ptid < 16) lbase[ptid] = atomicAdd(cnt + ptid, lcnt[ptid]);
            __syncthreads();
            { int it = 0;
#pragma unroll 1
              for (int m = m_lo; m < m_hi; m += m_st, ++it) if (ln < 4) { const unsigned x = stash[4 * it + ln]; const unsigned e = x >> 24, r = x & 0xffffffu; list[(size_t)e * (2 * M) + lbase[e] + r] = 2 * m + ln; } }
            __syncthreads();
            if (ptid < 32) lcnt[ptid] = 0u;
            __syncthreads();
            SEAM();
        }
        if (IN(5) || IN(6)) {
            PHASE_PTRS();
            if (ptid == 0) { int p = 0; for (int e = 0; e < NE; ++e) { const int c = (int)__hip_atomic_load(cnt + e, __ATOMIC_RELAXED, __HIP_MEMORY_SCOPE_AGENT); LC[LC_PRE + e] = (unsigned)p; LC[LC_CNT + e] = (unsigned)c; p += (c + 255) / 256; } LC[LC_PRE + 16] = (unsigned)p; }
            __syncthreads();
        }
        if (IN(5)) for (int rep = 0; rep < NREP(5); ++rep) {
            PHASE_PTRS();
            pg8::MoeSched S{(const volatile LAS int*)(LC + LC_PRE), (const volatile LAS int*)(LC + LC_CNT), list, pG, pvcu, 8, DM, DM, 1, (const void*)(wl + WL_WGU), (size_t)2048 * 2048, MOE_F8_GU ? 1 : 2};
            pg8::EpiGU E{HE, list, MOE_F8_GU ? 1.f / WSCALE8 : 1.f, MOE_F8_DN ? HESCALE8 : 0.f};
            if (MOE_F8_GU) pg8::gemm_phase<true>(lds, LC + LC_TAB, wave, (const void*)(wsp + WS_H1Q), DM, S, E);
            else pg8::gemm_phase<false>(lds, LC + LC_TAB, wave, H1, DM, S, E);
            FILL((int)LC[LC_PRE + 16] * 8, pvcu, FILL_D1, FILL_F1);
            SEAM();
        }
        if (IN(6)) for (int rep = 0; rep < NREP(6); ++rep) {
            PHASE_PTRS();
            pg8::MoeSched S{(const volatile LAS int*)(LC + LC_PRE), (const volatile LAS int*)(LC + LC_CNT), list, pG, pvcu, 8, EFF, EFF, 0, (const void*)(wl + WL_WD), (size_t)2048 * 1024, MOE_F8_DN ? 1 : 2};
            pg8::EpiDown E{Y, list, MOE_F8_DN ? 1.f / (WDSCALE8 * HESCALE8) : 1.f, Y_F8 ? YSCALE8 : 0.f};
            if (MOE_F8_DN) pg8::gemm_phase<true>(lds, LC + LC_TAB, wave, HE, EFF, S, E);
            else pg8::gemm_phase<false>(lds, LC + LC_TAB, wave, HE, EFF, S, E);
            FILL((int)LC[LC_PRE + 16] * 8, pvcu, FILL_F1, FILL_G1);
            SEAM();
        }
        if (IN(7)) for (int rep = 0; rep < NREP(7); ++rep) {
            PHASE_PTRS(); const float* ln2_g = GIN(21); const float* ln2_b = GIN(22);
            const int ln = plane;
#pragma unroll 1
            for (int m = 2 * pgw; m < M; m += 2 * pNGW) { asm volatile("" ::: "memory"); combine_rows2(m, H1, Y, wts, ln2_g + l * DM, ln2_b + l * DM, H, (float*)(GAS float*)ap_->out, l == DEPTH - 1, ln); }
            SEAM();
        }
    }
#undef IN
#undef SEAM
#undef lane
#undef tid
}

static int g_grid = 0;
extern "C" void kernel_launch(void* const* d_in, const int* in_sizes, int n_in, void* d_out, int out_size, void* d_ws, size_t ws_size, hipStream_t stream) {
    if (n_in != 23 || ws_size < WS_END4 || out_size != BATCH * SEQ * DM) { fprintf(stderr, "kernel_launch: unexpected shapes: n_in %d ws %zu (need %zu) out %d\n", n_in, ws_size, (size_t)WS_END4, out_size); return; }
    if (g_grid == 0) {
        int dev = 0, cus = 0;
        if (hipGetDevice(&dev) != hipSuccess || hipDeviceGetAttribute(&cus, hipDeviceAttributeMultiprocessorCount, dev) != hipSuccess) { g_grid = -1; return; }
        if (hipFuncSetAttribute((const void*)fwd, hipFuncAttributeMaxDynamicSharedMemorySize, LDS_BYTES) != hipSuccess) { fprintf(stderr, "hipFuncSetAttribute failed\n"); g_grid = -1; return; }
        g_grid = cus;
    }
    if (g_grid < 0) return;
    unsigned char* ws = (unsigned char*)d_ws;
    (void)hipMemsetAsync(ws + WS_CTL, 0, CTL_ZERO_BYTES, stream);
    Args a{}; for (int i = 0; i < 23; ++i) a.in[i] = (const float*)d_in[i]; a.out = (float*)d_out; a.ws = ws;
    a.l_lo = 0; a.l_hi = DEPTH; a.ph_lo = 0; a.ph_hi = 8; a.prologue = 3; a.use_bar = 1;
    hipLaunchKernelGGL(fwd, dim3(g_grid), dim3(NWAVES * 64), LDS_BYTES, stream, a);
}
```
